# Optimizing an MI355X kernel written in HIP

```python
import math
import jax
import jax.numpy as jnp
from jax import lax
import numpy as np

D_MODEL = 1024
BATCH = 16
SEQ = 2048
DEPTH = 2

CHUNK = 64
Q_BLOCK = 128
N_MIXERS = 2
N_HEADS = 16
HEAD_DIM = 64
D_ATT = N_HEADS * HEAD_DIM
SSM_GROUP = 16
D_SSM = D_MODEL
N_GROUPS = D_SSM // SSM_GROUP
STATE = 64
_FF_RAW = -(-8 * D_MODEL // 3)
D_FF = -(-_FF_RAW // 256) * 256
N_FOX = (DEPTH + 1) // 2
N_S5 = DEPTH // 2
EPS = 1e-6
DT_MIN = 1e-3
DT_MAX = 1e-1

kernel_name = 'hybrid_fox_s5_sandwich_trunk'


def rmsnorm(x, gain):
    xf = x.astype(jnp.float32)
    y = xf * lax.rsqrt(jnp.mean(xf * xf, axis=-1, keepdims=True) + EPS)
    return (y * gain.astype(jnp.float32)).astype(x.dtype)


def fox_mixer(h, w_in, b_f, q_gain, k_gain, w_out):
    bsz, seq_len, _ = h.shape
    proj = h @ w_in
    q = proj[..., :D_ATT]
    k = proj[..., D_ATT:2 * D_ATT]
    v = proj[..., 2 * D_ATT:3 * D_ATT]
    gate = proj[..., 3 * D_ATT:4 * D_ATT]
    f_logit = proj[..., 4 * D_ATT:]

    def heads(t):
        return t.reshape(bsz, seq_len, N_HEADS, HEAD_DIM).transpose(0, 2, 1, 3)

    q = rmsnorm(heads(q), q_gain)
    k = rmsnorm(heads(k), k_gain)
    v = heads(v)
    log_f = jax.nn.log_sigmoid(f_logit.astype(jnp.float32) + b_f.astype(jnp.float32))
    c = jnp.cumsum(log_f, axis=1).transpose(0, 2, 1)
    scale = HEAD_DIM ** -0.5

    outs = []
    for blk in range(seq_len // Q_BLOCK):
        q0 = blk * Q_BLOCK
        k_end = q0 + Q_BLOCK
        qb = q[:, :, q0:k_end]
        kb = k[:, :, :k_end]
        vb = v[:, :, :k_end]
        s = jnp.einsum('bhqd,bhkd->bhqk', qb, kb).astype(jnp.float32) * scale
        s = s + c[:, :, q0:k_end, None] - c[:, :, None, :k_end]
        q_pos = q0 + jnp.arange(Q_BLOCK)
        mask = q_pos[:, None] >= jnp.arange(k_end)[None, :]
        s = jnp.where(mask, s, -jnp.inf)
        p = jax.nn.softmax(s, axis=-1).astype(vb.dtype)
        outs.append(jnp.einsum('bhqk,bhkd->bhqd', p, vb))
    o = jnp.concatenate(outs, axis=2)
    o = o.transpose(0, 2, 1, 3).reshape(bsz, seq_len, D_ATT)
    o = o * jax.nn.sigmoid(gate)
    return o @ w_out


def _complex_linear_combine(e1, e2):
    a1r, a1i, b1r, b1i = e1
    a2r, a2i, b2r, b2i = e2
    return (a2r * a1r - a2i * a1i,
            a2r * a1i + a2i * a1r,
            a2r * b1r - a2i * b1i + b2r,
            a2r * b1i + a2i * b1r + b2i)


def s5_mixer(h, w_in, log_dt, lam_re, lam_im, b_re, b_im, c_re, c_im, d_skip, w_glu, w_out):
    f32 = jnp.float32
    bsz, seq_len, _ = h.shape
    u = (h @ w_in).astype(f32)
    lam_re = lam_re.astype(f32)
    lam_im = lam_im.astype(f32)
    dt = jnp.exp(log_dt.astype(f32))[:, None]
    mag = jnp.exp(lam_re * dt)
    a_re = mag * jnp.cos(lam_im * dt)
    a_im = mag * jnp.sin(lam_im * dt)
    den = lam_re * lam_re + lam_im * lam_im
    n_re = a_re - 1.0
    z_re = (n_re * lam_re + a_im * lam_im) / den
    z_im = (a_im * lam_re - n_re * lam_im) / den
    b_re = b_re.astype(f32)
    b_im = b_im.astype(f32)
    bb_re = z_re[..., None] * b_re - z_im[..., None] * b_im
    bb_im = z_re[..., None] * b_im + z_im[..., None] * b_re
    c_re = c_re.astype(f32)
    c_im = c_im.astype(f32)

    n_chunks = seq_len // CHUNK
    u_chunks = u.reshape(bsz, n_chunks, CHUNK, N_GROUPS, SSM_GROUP).transpose(1, 0, 2, 3, 4)

    def step(carry, u_c):
        s_re, s_im = carry
        bu_re = jnp.einsum('gpc,bkgc->bkgp', bb_re, u_c)
        bu_im = jnp.einsum('gpc,bkgc->bkgp', bb_im, u_c)
        bu_re = bu_re.at[:, 0].add(a_re * s_re - a_im * s_im)
        bu_im = bu_im.at[:, 0].add(a_re * s_im + a_im * s_re)
        a_seq_re = jnp.broadcast_to(a_re, bu_re.shape)
        a_seq_im = jnp.broadcast_to(a_im, bu_im.shape)
        _, _, x_re, x_im = lax.associative_scan(
            _complex_linear_combine, (a_seq_re, a_seq_im, bu_re, bu_im), axis=1)
        y = (jnp.einsum('gcp,bkgp->bkgc', c_re, x_re)
             - jnp.einsum('gcp,bkgp->bkgc', c_im, x_im))
        return (x_re[:, -1], x_im[:, -1]), y

    init = (jnp.zeros((bsz, N_GROUPS, STATE), f32), jnp.zeros((bsz, N_GROUPS, STATE), f32))
    _, y = lax.scan(step, init, u_chunks)
    y = y.transpose(1, 0, 2, 3, 4).reshape(bsz, seq_len, D_SSM)
    y = y + d_skip.astype(f32) * u
    y = jax.nn.gelu(y).astype(h.dtype)
    y = y * jax.nn.sigmoid(y @ w_glu)
    return y @ w_out


def swiglu(h, w_gate, w_up, w_down):
    return (jax.nn.silu(h @ w_gate) * (h @ w_up)) @ w_down


def setup_inputs(seed: int = 0) -> dict:
    key = jax.random.key(seed)
    ks = jax.random.split(key, 24)
    f32 = jnp.float32

    def nrm(k, shape, scale):
        return jax.random.normal(k, shape, f32) * scale

    def gain(k, shape):
        return 1.0 + 0.02 * jax.random.normal(k, shape, f32)

    x = jax.random.normal(ks[0], (BATCH, SEQ, D_MODEL), f32)
    fox_w_in = nrm(ks[1], (N_FOX, D_MODEL, 4 * D_ATT + N_HEADS), D_MODEL ** -0.5)
    fox_b_f = jax.random.uniform(ks[2], (N_FOX, N_HEADS), f32, minval=1.0, maxval=5.0)
    fox_q_gain = gain(ks[3], (N_FOX, HEAD_DIM))
    fox_k_gain = gain(ks[4], (N_FOX, HEAD_DIM))
    fox_w_out = nrm(ks[5], (N_FOX, D_ATT, D_MODEL), D_ATT ** -0.5)
    s5_w_in = nrm(ks[6], (N_S5, D_MODEL, D_SSM), D_MODEL ** -0.5)
    s5_log_dt = jax.random.uniform(ks[7], (N_S5, N_GROUPS), f32,
                                   minval=math.log(DT_MIN), maxval=math.log(DT_MAX))
    s5_lam_re = -0.5 + 0.01 * jax.random.normal(ks[8], (N_S5, N_GROUPS, STATE), f32)
    s5_lam_im = (math.pi * jnp.arange(STATE, dtype=f32)
                 + 0.01 * jax.random.normal(ks[9], (N_S5, N_GROUPS, STATE), f32))
    s5_b_re = nrm(ks[10], (N_S5, N_GROUPS, STATE, SSM_GROUP), (2 * SSM_GROUP) ** -0.5)
    s5_b_im = nrm(ks[11], (N_S5, N_GROUPS, STATE, SSM_GROUP), (2 * SSM_GROUP) ** -0.5)
    s5_c_re = nrm(ks[12], (N_S5, N_GROUPS, SSM_GROUP, STATE), (2 * STATE) ** -0.5)
    s5_c_im = nrm(ks[13], (N_S5, N_GROUPS, SSM_GROUP, STATE), (2 * STATE) ** -0.5)
    s5_d = nrm(ks[14], (N_S5, D_SSM), 1.0)
    s5_w_glu = nrm(ks[15], (N_S5, D_SSM, D_SSM), D_SSM ** -0.5)
    s5_w_out = nrm(ks[16], (N_S5, D_SSM, D_MODEL), D_SSM ** -0.5)
    mix_pre_gain = gain(ks[17], (DEPTH, D_MODEL))
    mix_post_gain = gain(ks[18], (DEPTH, D_MODEL))
    ffn_pre_gain = gain(ks[19], (DEPTH, D_MODEL))
    ffn_post_gain = gain(ks[20], (DEPTH, D_MODEL))
    ffn_w_gate = nrm(ks[21], (DEPTH, D_MODEL, D_FF), D_MODEL ** -0.5)
    ffn_w_up = nrm(ks[22], (DEPTH, D_MODEL, D_FF), D_MODEL ** -0.5)
    ffn_w_down = nrm(ks[23], (DEPTH, D_FF, D_MODEL), D_FF ** -0.5)
    return {
        'x': x,
        'fox_w_in': fox_w_in, 'fox_b_f': fox_b_f, 'fox_q_gain': fox_q_gain,
        'fox_k_gain': fox_k_gain, 'fox_w_out': fox_w_out,
        's5_w_in': s5_w_in, 's5_log_dt': s5_log_dt, 's5_lam_re': s5_lam_re,
        's5_lam_im': s5_lam_im, 's5_b_re': s5_b_re, 's5_b_im': s5_b_im,
        's5_c_re': s5_c_re, 's5_c_im': s5_c_im, 's5_d': s5_d,
        's5_w_glu': s5_w_glu, 's5_w_out': s5_w_out,
        'mix_pre_gain': mix_pre_gain, 'mix_post_gain': mix_post_gain,
        'ffn_pre_gain': ffn_pre_gain, 'ffn_post_gain': ffn_post_gain,
        'ffn_w_gate': ffn_w_gate, 'ffn_w_up': ffn_w_up, 'ffn_w_down': ffn_w_down,
    }


def reference(x, fox_w_in, fox_b_f, fox_q_gain, fox_k_gain, fox_w_out,
              s5_w_in, s5_log_dt, s5_lam_re, s5_lam_im, s5_b_re, s5_b_im,
              s5_c_re, s5_c_im, s5_d, s5_w_glu, s5_w_out,
              mix_pre_gain, mix_post_gain, ffn_pre_gain, ffn_post_gain,
              ffn_w_gate, ffn_w_up, ffn_w_down):
    for i in range(DEPTH):
        j = i // N_MIXERS
        h = rmsnorm(x, mix_pre_gain[i])
        if i % N_MIXERS == 0:
            m = fox_mixer(h, fox_w_in[j], fox_b_f[j], fox_q_gain[j], fox_k_gain[j], fox_w_out[j])
        else:
            m = s5_mixer(h, s5_w_in[j], s5_log_dt[j], s5_lam_re[j], s5_lam_im[j],
                         s5_b_re[j], s5_b_im[j], s5_c_re[j], s5_c_im[j], s5_d[j],
                         s5_w_glu[j], s5_w_out[j])
        x = x + rmsnorm(m, mix_post_gain[i])
        h = rmsnorm(x, ffn_pre_gain[i])
        x = x + rmsnorm(swiglu(h, ffn_w_gate[i], ffn_w_up[i], ffn_w_down[i]), ffn_post_gain[i])
    return x
```

```cpp
#include <hip/hip_runtime.h>
#include <hip/hip_bf16.h>
#include <cstdio>
#include <cstdint>
namespace pg8 {
#define PG8_LAS __attribute__((address_space(3)))
typedef unsigned short bf16_t;
typedef short bf16x8 __attribute__((ext_vector_type(8)));
typedef float f32x4 __attribute__((ext_vector_type(4)));
typedef unsigned u32x4 __attribute__((ext_vector_type(4)));
constexpr int BM = 256, BK = 64, HALF = 128, HTB = HALF * BK * 2  , STAGE_BYTES = 8 * HTB, NXCD = 8, WGM = 8;

__host__ __device__ __forceinline__ int lds_byte(int r, int c) { const int st = (r >> 4) * 2 + (c >> 5), rr = r & 15, cc = c & 31, ob = rr * 64 + cc * 2; return st * 1024 + (ob ^ (((ob >> 9) & 1) << 5)); }
__host__ __device__ __forceinline__ void stage_rc(int b, int& R, int& C) { const int st = b / 1024, sb = b % 1024, swz = sb ^ (((sb >> 9) & 1) << 5); R = (st >> 1) * 16 + swz / 64; C = (st & 1) * 32 + (swz % 64) / 2; }
__host__ __device__ __forceinline__ int perm32(int rho) { const int n = rho >> 4, i = rho & 15; return 8 * (i >> 2) + 4 * n + (i & 3); }

struct Unit { int pm, pn; };
struct Gemm { const bf16_t* A; const bf16_t* Bt; int M, N, K; };

struct StaticOrder {
    int nM, nN, nwg, G, c;
    __host__ __device__ void init(int M, int N, int G_, int c_) { nM = M / BM; nN = N / BM; nwg = nM * nN; G = G_; c = c_; }
    __host__ __device__ bool next(int i, Unit& u) const {
        const long L = (long)i * G + c; if (L >= nwg) return false;
        int wgid = (int)L; { const int q = nwg / NXCD, r = nwg % NXCD, xcd = wgid % NXCD, off = wgid / NXCD; wgid = (xcd < r ? xcd * (q + 1) : r * (q + 1) + (xcd - r) * q) + off; }
        const int nig = WGM * nN, gid = wgid / nig, fm = gid * WGM, gsz = (nM - fm) < WGM ? (nM - fm) : WGM;
        u.pm = fm + ((wgid % nig) % gsz); u.pn = (wgid % nig) / gsz; return true;
    }
    __device__ __forceinline__ void a_ready(const Unit&) const {}
    __device__ __forceinline__ void done(const Unit&) const {}
};

__device__ __forceinline__ unsigned cvt_pk_bf16(float lo, float hi) { unsigned r; asm volatile("v_cvt_pk_bf16_f32 %0, %1, %2" : "=v"(r) : "v"(lo), "v"(hi)); return r; }
typedef float f32x2 __attribute__((ext_vector_type(2)));
__device__ __forceinline__ f32x2 gelu_pk(f32x2 v) {
    const f32x2 av = __builtin_elementwise_abs(v), d = av * 0.2316418882f + 1.0f;
    f32x2 t; t.x = __builtin_amdgcn_rcpf(d.x); t.y = __builtin_amdgcn_rcpf(d.y);
    f32x2 q = t * 0.5307027145f + (-0.7265760135f); q = q * t + 0.7107068705f; q = q * t + (-0.142248368f); q = q * t + 0.127414796f; q = q * t;
    const f32x2 s = (v * v) * (-0.72134752044f);
    f32x2 e; e.x = __builtin_amdgcn_exp2f(s.x); e.y = __builtin_amdgcn_exp2f(s.y);
    const f32x2 m = v * (q * e), r = v - m;
    f32x2 o; o.x = v.x < 0.f ? m.x : r.x; o.y = v.y < 0.f ? m.y : r.y; return o;
}

template <int ACT  > struct EpiBf16 {
    static constexpr bool PERM = true, AFTER_DRAIN = false; static_assert(ACT == 0 || ACT == 1, "EpiBf16: ACT is 0 (none) or 1 (gelu_pk)");
    bf16_t* O; int ldc; const float* bias; int split_cols; size_t split_stride; float scale0;
    __device__ __forceinline__ void operator()(const f32x4 (&acc)[2][2][4][2], const Unit& u, int wr, int wc, int fr, int fq) const {
        const int row0 = u.pm * BM + wr * 64 + fr; int colt = u.pn * BM; bf16_t* base = O;
        float sc = 1.f; if (split_cols) { const int t = colt / split_cols; base += (size_t)t * split_stride; colt -= t * split_cols; if (t == 0) sc = scale0; }
        const int col0 = colt + wc * 32 + 8 * fq, bcol0 = u.pn * BM + wc * 32 + 8 * fq;
        f32x4 bv[2][2];
#pragma unroll
        for (int bj = 0; bj < 2; ++bj)
#pragma unroll
            for (int n = 0; n < 2; ++n) bv[bj][n] = bias ? *(const f32x4*)(bias + bcol0 + bj * HALF + 4 * n) : (f32x4){0.f, 0.f, 0.f, 0.f};
#pragma unroll
        for (int ai = 0; ai < 2; ++ai)
#pragma unroll
            for (int m = 0; m < 4; ++m) { bf16_t* rowp = base + (size_t)(row0 + ai * HALF + m * 16) * ldc + col0;
#pragma unroll
                for (int bj = 0; bj < 2; ++bj) { f32x4 v0 = acc[ai][bj][m][0] + bv[bj][0], v1 = acc[ai][bj][m][1] + bv[bj][1];
                    if (ACT == 1) { f32x2 a = gelu_pk((f32x2){v0[0], v0[1]}), b = gelu_pk((f32x2){v0[2], v0[3]}), c = gelu_pk((f32x2){v1[0], v1[1]}), d = gelu_pk((f32x2){v1[2], v1[3]});
                        v0 = (f32x4){a.x, a.y, b.x, b.y}; v1 = (f32x4){c.x, c.y, d.x, d.y}; }
                    v0 = v0 * sc; v1 = v1 * sc; u32x4 w; w.x = cvt_pk_bf16(v0[0], v0[1]); w.y = cvt_pk_bf16(v0[2], v0[3]); w.z = cvt_pk_bf16(v1[0], v1[1]); w.w = cvt_pk_bf16(v1[2], v1[3]);
                    *(u32x4*)(rowp + bj * HALF) = w; } }
    }
};

struct PanelStats {
    unsigned* xbuf;
    unsigned* cnt;
    unsigned* tmo;
    int ntn; float eps;
    unsigned code;
    __device__ __forceinline__ bool run(const f32x4 (&v)[2][2][4][2], const Unit& u, int wr, int wc, int fr, int fq, PG8_LAS unsigned char* lds, int wid, int lane) const {
        typedef float f32x2v __attribute__((ext_vector_type(2)));
        PG8_LAS f32x2v* P = (PG8_LAS f32x2v*)lds;
        PG8_LAS f32x2v* S = (PG8_LAS f32x2v*)(lds + 8192);
        PG8_LAS unsigned* flag = (PG8_LAS unsigned*)(lds + 8192 + 2048);
#pragma unroll
        for (int ai = 0; ai < 2; ++ai)
#pragma unroll
            for (int m = 0; m < 4; ++m) {
                float s = 0.f;
#pragma unroll
                for (int bj = 0; bj < 2; ++bj)
#pragma unroll
                    for (int n = 0; n < 2; ++n) { const f32x4 x = v[ai][bj][m][n]; s += (x[0] + x[1]) + (x[2] + x[3]); }
                s += __shfl_xor(s, 16); s += __shfl_xor(s, 32);
                const float mw = s * (1.0f / 64.0f); float q = 0.f;
#pragma unroll
                for (int bj = 0; bj < 2; ++bj)
#pragma unroll
                    for (int n = 0; n < 2; ++n) { const f32x4 d = v[ai][bj][m][n] - mw; q += (d[0] * d[0] + d[1] * d[1]) + (d[2] * d[2] + d[3] * d[3]); }
                q += __shfl_xor(q, 16); q += __shfl_xor(q, 32);
                if (fq == 0) P[(ai * HALF + wr * 64 + m * 16 + fr) * 4 + wc] = (f32x2v){mw, q};
            }
        asm volatile("s_waitcnt lgkmcnt(0)" ::: "memory"); __builtin_amdgcn_s_barrier(); asm volatile("" ::: "memory");
#if defined(BROKEN_EXCHANGE_NO_WAIT)
#warning BROKEN CONTROL BUILD: the row-statistics exchange does not wait; results are wrong by design
        if (blockIdx.x >= 64) { const long long t0_ = clock64(); while (clock64() - t0_ < 60000) __builtin_amdgcn_s_sleep(8); }
#endif
        const int row = wid * 32 + (lane & 31);
        if (lane < 32) {
            const f32x2v a = P[row * 4 + 0], b = P[row * 4 + 1], c = P[row * 4 + 2], d = P[row * 4 + 3];
            const float mt = (a.x + b.x + c.x + d.x) * 0.25f;
            const float da = a.x - mt, db = b.x - mt, dc = c.x - mt, dd = d.x - mt;
            const float m2 = (a.y + b.y) + (c.y + d.y) + 64.0f * ((da * da + db * db) + (dc * dc + dd * dd));
            unsigned long long* slot = (unsigned long long*)xbuf + ((size_t)(u.pm * BM + row) * 4 + u.pn);
            __hip_atomic_store(slot, ((unsigned long long)__float_as_uint(m2) << 32) | __float_as_uint(mt), __ATOMIC_RELAXED, __HIP_MEMORY_SCOPE_AGENT);
        }
        asm volatile("s_waitcnt vmcnt(0)" ::: "memory");
        if (lane == 0) __hip_atomic_fetch_add(cnt + 64 * u.pm, 1u, __ATOMIC_RELAXED, __HIP_MEMORY_SCOPE_AGENT);
        if (wid == 0) {
            bool dead = false; const unsigned long long t0 = __builtin_amdgcn_s_memrealtime(); const unsigned want = 8u * (unsigned)ntn;
            for (;;) {
#if defined(BROKEN_EXCHANGE_NO_WAIT)
                break;
#endif
                if ((unsigned)__builtin_amdgcn_readfirstlane(__hip_atomic_load(cnt + 64 * u.pm, __ATOMIC_RELAXED, __HIP_MEMORY_SCOPE_AGENT)) >= want) break;
                if (__builtin_amdgcn_s_memrealtime() - t0 > 2000000ull) {
                    if (lane == 0) { unsigned expect = 0u; __hip_atomic_compare_exchange_strong(tmo + 1, &expect, code | (unsigned)(u.pm & 0xff), __ATOMIC_RELAXED, __ATOMIC_RELAXED, __HIP_MEMORY_SCOPE_AGENT);
                                     __hip_atomic_store(tmo, 1u, __ATOMIC_RELAXED, __HIP_MEMORY_SCOPE_AGENT); }
                    dead = true; break; }
                __builtin_amdgcn_s_sleep(2);
            }
            __builtin_amdgcn_fence(__ATOMIC_ACQUIRE, "agent");
            if (lane == 0) flag[0] = dead ? 1u : 0u;
        }
        asm volatile("s_waitcnt vmcnt(0) lgkmcnt(0)" ::: "memory"); __builtin_amdgcn_s_barrier(); asm volatile("" ::: "memory");
        const bool bad = flag[0] != 0u;
        if (lane < 32) {
            const unsigned long long* slot = (const unsigned long long*)xbuf + (size_t)(u.pm * BM + row) * 4; float mt[4], m2[4]; float ms = 0.f;
#pragma unroll
            for (int t = 0; t < 4; ++t) { if (t < ntn) { const unsigned long long w = __hip_atomic_load(slot + t, __ATOMIC_RELAXED, __HIP_MEMORY_SCOPE_AGENT); mt[t] = __uint_as_float((unsigned)w); m2[t] = __uint_as_float((unsigned)(w >> 32)); } else { mt[t] = 0.f; m2[t] = 0.f; } ms += mt[t]; }
            const float mean = ms / (float)ntn; float q = 0.f;
#pragma unroll
            for (int t = 0; t < 4; ++t) if (t < ntn) { const float dm = mt[t] - mean; q += m2[t] + 256.0f * dm * dm; }
            S[row] = (f32x2v){mean, 1.0f / sqrtf(q / (256.0f * (float)ntn) + eps)};
        }
        asm volatile("s_waitcnt lgkmcnt(0)" ::: "memory"); __builtin_amdgcn_s_barrier(); asm volatile("" ::: "memory");
        return bad;
    }
};
struct EpiLnRes {
    static constexpr bool PERM = false, AFTER_DRAIN = true;
    const float* base; float* out; int ldc; const float* bias; PanelStats st; unsigned poison;
    __device__ __forceinline__ void fused(f32x4 (&acc)[2][2][4][2], const Unit& u, int wr, int wc, int fr, int fq, PG8_LAS unsigned char* lds, int wid, int lane) const {
        typedef float f32x2v __attribute__((ext_vector_type(2)));
        const PG8_LAS f32x2v* S = (const PG8_LAS f32x2v*)(lds + 8192);
        const int col0 = u.pn * BM + wc * 32 + 4 * fq;
#pragma unroll
        for (int bj = 0; bj < 2; ++bj)
#pragma unroll
            for (int n = 0; n < 2; ++n) { const f32x4 bv = bias ? *(const f32x4*)(bias + col0 + bj * HALF + n * 16) : (f32x4){0.f, 0.f, 0.f, 0.f};
#pragma unroll
                for (int ai = 0; ai < 2; ++ai)
#pragma unroll
                    for (int m = 0; m < 4; ++m) acc[ai][bj][m][n] += bv; }
        f32x4 pre[4][2][2];
#pragma unroll
        for (int m = 0; m < 4; ++m) { const size_t off = (size_t)(u.pm * BM + wr * 64 + m * 16 + fr) * ldc + col0;
#pragma unroll
            for (int bj = 0; bj < 2; ++bj)
#pragma unroll
                for (int n = 0; n < 2; ++n) pre[m][bj][n] = *(const f32x4*)(base + off + bj * HALF + n * 16); }
        const bool bad = st.run(acc, u, wr, wc, fr, fq, lds, wid, lane) || poison != 0u;
        const float qnan = __builtin_nanf("");
#pragma unroll
        for (int ai = 0; ai < 2; ++ai)
#pragma unroll
            for (int m = 0; m < 4; ++m) { const int r = ai * HALF + wr * 64 + m * 16 + fr; const f32x2v sr = S[r]; const size_t off = (size_t)(u.pm * BM + r) * ldc + col0;
#pragma unroll
                for (int bj = 0; bj < 2; ++bj)
#pragma unroll
                    for (int n = 0; n < 2; ++n) { const f32x4 bs = ai == 0 ? pre[m][bj][n] : *(const f32x4*)(base + off + bj * HALF + n * 16); f32x4 o = bs + (acc[ai][bj][m][n] - sr.x) * sr.y;
                        if (bad) o = (f32x4){qnan, qnan, qnan, qnan}; *(f32x4*)(out + off + bj * HALF + n * 16) = o; }
                if (m & 1) asm volatile("" ::: "memory"); }
    }
};
struct EpiLnResLn {
    static constexpr bool PERM = false, AFTER_DRAIN = true;
    const float* base; float* out; bf16_t* xn; int ldc; const float* bias; PanelStats st1, st2; unsigned poison;
    __device__ __forceinline__ void fused(f32x4 (&acc)[2][2][4][2], const Unit& u, int wr, int wc, int fr, int fq, PG8_LAS unsigned char* lds, int wid, int lane) const {
        typedef float f32x2v __attribute__((ext_vector_type(2))); typedef unsigned u32x2v __attribute__((ext_vector_type(2)));
        const PG8_LAS f32x2v* S = (const PG8_LAS f32x2v*)(lds + 8192);
        const int col0 = u.pn * BM + wc * 32 + 4 * fq;
#pragma unroll
        for (int bj = 0; bj < 2; ++bj)
#pragma unroll
            for (int n = 0; n < 2; ++n) { const f32x4 bv = bias ? *(const f32x4*)(bias + col0 + bj * HALF + n * 16) : (f32x4){0.f, 0.f, 0.f, 0.f};
#pragma unroll
                for (int ai = 0; ai < 2; ++ai)
#pragma unroll
                    for (int m = 0; m < 4; ++m) acc[ai][bj][m][n] += bv; }
        bool bad = st1.run(acc, u, wr, wc, fr, fq, lds, wid, lane) || poison != 0u;
        const float qnan = __builtin_nanf("");
#pragma unroll
        for (int ai = 0; ai < 2; ++ai)
#pragma unroll
            for (int m = 0; m < 4; ++m) { const int r = ai * HALF + wr * 64 + m * 16 + fr; const f32x2v sr = S[r]; const size_t off = (size_t)(u.pm * BM + r) * ldc + col0;
#pragma unroll
                for (int bj = 0; bj < 2; ++bj)
#pragma unroll
                    for (int n = 0; n < 2; ++n) { const f32x4 bs = *(const f32x4*)(base + off + bj * HALF + n * 16); acc[ai][bj][m][n] = bs + (acc[ai][bj][m][n] - sr.x) * sr.y; }
                asm volatile("" : "+v"(acc[ai][0][m][0]), "+v"(acc[ai][0][m][1]), "+v"(acc[ai][1][m][0]), "+v"(acc[ai][1][m][1]));
                if (m & 1) asm volatile("" ::: "memory"); }
        const bool bad1 = bad;
        bad = st2.run(acc, u, wr, wc, fr, fq, lds, wid, lane) || bad;
#pragma unroll
        for (int ai = 0; ai < 2; ++ai)
#pragma unroll
            for (int m = 0; m < 4; ++m) { const int r = ai * HALF + wr * 64 + m * 16 + fr; const f32x2v sr = S[r]; const size_t off = (size_t)(u.pm * BM + r) * ldc + col0;
#pragma unroll
                for (int bj = 0; bj < 2; ++bj)
#pragma unroll
                    for (int n = 0; n < 2; ++n) { const f32x4 x1 = acc[ai][bj][m][n]; *(f32x4*)(out + off + bj * HALF + n * 16) = bad1 ? (f32x4){qnan, qnan, qnan, qnan} : x1;
                        const f32x4 o = (x1 - sr.x) * sr.y; u32x2v w; w.x = cvt_pk_bf16(o[0], o[1]); w.y = cvt_pk_bf16(o[2], o[3]);
                        if (bad) { w.x = 0x7fc07fc0u; w.y = 0x7fc07fc0u; } *(u32x2v*)(xn + off + bj * HALF + n * 16) = w; }
                asm volatile("" ::: "memory"); }
    }
};

template <class Epi, class Sched, bool ALIGN_EPI = false, bool SP2 = false>
__device__ __forceinline__ void gemm_phase(PG8_LAS unsigned char* lds, const Gemm g, const Sched& S, const Epi& E) {
    const int tid = threadIdx.x, wid = __builtin_amdgcn_readfirstlane(tid >> 6), lane = tid & 63, wr = wid >> 2, wc = wid & 3, fr = lane & 15, fq = lane >> 4;
    const int K = g.K, nt = K / BK;
    unsigned voffA[2], voffB[2];
#pragma unroll
    for (int i = 0; i < 2; ++i) { int R, C; stage_rc(tid * 16 + i * 8192, R, C); const int Rb = Epi::PERM ? ((R & ~31) + perm32(R & 31)) : R;
        voffA[i] = (unsigned)(R * K + C) * 2u; voffB[i] = (unsigned)(Rb * K + C) * 2u; }
    const size_t kstep = (size_t)(BK * 2);
    const size_t hstep = (size_t)HALF * K * 2;
    const size_t tstep = 2 * hstep;
    const unsigned ldsw = (unsigned)wid * 1024u;
    const int aoff = lds_byte(wr * 64 + fr, fq * 8), boff = lds_byte(wc * 32 + fr, fq * 8);
#define PG8_SA(b, h) (((b) * 2 + (h)) * HTB)
#define PG8_SB(b, h) ((4 + (b) * 2 + (h)) * HTB)
#define PG8_STAGE(bufoff, gbase, voff) do { _Pragma("unroll") for (int _i = 0; _i < 2; ++_i) \
        __builtin_amdgcn_global_load_lds((const unsigned*)((const char*)(gbase) + (voff)[_i]), (PG8_LAS unsigned*)(lds + (bufoff) + ldsw + _i * 8192), 16, 0, 0); } while (0)
#define PG8_LDA(dst, b, h) do { _Pragma("unroll") for (int m = 0; m < 4; ++m) _Pragma("unroll") for (int k = 0; k < 2; ++k) dst[m][k] = *(const PG8_LAS bf16x8*)(lds + PG8_SA(b, h) + aoff + m * 2048 + k * 1024); } while (0)
#define PG8_LDB(dst, b, h) do { _Pragma("unroll") for (int n = 0; n < 2; ++n) _Pragma("unroll") for (int k = 0; k < 2; ++k) dst[n][k] = *(const PG8_LAS bf16x8*)(lds + PG8_SB(b, h) + boff + n * 2048 + k * 1024); } while (0)
#define PG8_MMA(ai, bj, At, Bt) do { __builtin_amdgcn_s_setprio(1); _Pragma("unroll") for (int m = 0; m < 4; ++m) _Pragma("unroll") for (int n = 0; n < 2; ++n) _Pragma("unroll") for (int k = 0; k < 2; ++k) \
        acc[ai][bj][m][n] = __builtin_amdgcn_mfma_f32_16x16x32_bf16(Bt[n][k], At[m][k], acc[ai][bj][m][n], 0, 0, 0); __builtin_amdgcn_s_setprio(0); } while (0)
#define PG8_WAIT_V(n) asm volatile("s_waitcnt vmcnt(" #n ")" ::: "memory")
#define PG8_WAIT_L(n) asm volatile("s_waitcnt lgkmcnt(" #n ")" ::: "memory")
#define PG8_BAR __builtin_amdgcn_s_barrier()
#define PG8_SCHED __builtin_amdgcn_sched_barrier(0)
    Unit cur, nxt; int ui = 0;
    if (!S.next(0, cur)) return;
    f32x4 acc[2][2][4][2];
#pragma unroll
    for (int a = 0; a < 2; ++a)
#pragma unroll
        for (int b = 0; b < 2; ++b)
#pragma unroll
            for (int m = 0; m < 4; ++m)
#pragma unroll
                for (int n = 0; n < 2; ++n) acc[a][b][m][n] = (f32x4){0.f, 0.f, 0.f, 0.f};
    bf16x8 At[4][2], B0[2][2], B1[2][2];
    const char* cA = (const char*)g.A + (size_t)cur.pm * tstep; const char* cB = (const char*)g.Bt + (size_t)cur.pn * tstep;
    S.a_ready(cur);
    if constexpr (SP2) {
        PG8_STAGE(PG8_SB(0, 0), cB, voffB); PG8_STAGE(PG8_SB(0, 1), cB + hstep, voffB); PG8_STAGE(PG8_SA(0, 0), cA, voffA); PG8_STAGE(PG8_SA(0, 1), cA + hstep, voffA);
        if (wr == 1) PG8_BAR;
        PG8_WAIT_V(2); PG8_BAR;
        PG8_STAGE(PG8_SB(1, 0), cB + kstep, voffB); PG8_STAGE(PG8_SA(1, 0), cA + kstep, voffA); PG8_STAGE(PG8_SB(1, 1), cB + hstep + kstep, voffB);
        PG8_WAIT_V(6); PG8_BAR;
    } else {
        PG8_STAGE(PG8_SB(0, 0), cB, voffB); PG8_STAGE(PG8_SA(0, 0), cA, voffA); PG8_STAGE(PG8_SB(0, 1), cB + hstep, voffB); PG8_STAGE(PG8_SA(0, 1), cA + hstep, voffA);
        if (wr == 1) PG8_BAR;
        PG8_WAIT_V(4); PG8_BAR;
        PG8_STAGE(PG8_SB(1, 0), cB + kstep, voffB); PG8_STAGE(PG8_SA(1, 0), cA + kstep, voffA); PG8_STAGE(PG8_SB(1, 1), cB + hstep + kstep, voffB);
        PG8_WAIT_V(6); PG8_BAR;
    }
    for (;;) {
        const bool has_next = S.next(ui + 1, nxt);
        const char* nA = has_next ? (const char*)g.A + (size_t)nxt.pm * tstep : cA; const char* nB = has_next ? (const char*)g.Bt + (size_t)nxt.pn * tstep : cB;
        for (int t = 0; t < nt; t += 2) {
            const bool last = (t == nt - 2);
            const char* a1 = cA + (size_t)(t + 1) * kstep;
            const char* a2 = last ? nA : cA + (size_t)(t + 2) * kstep; const char* b2 = last ? nB : cB + (size_t)(t + 2) * kstep;
            const char* a3 = a2 + kstep; const char* b3 = b2 + kstep;
            if (last && has_next) S.a_ready(nxt);
            if constexpr (SP2) {
            PG8_LDB(B0, 0, 0); PG8_LDB(B1, 0, 1); PG8_SCHED; PG8_LDA(At, 0, 0); PG8_STAGE(PG8_SA(1, 1), a1 + hstep, voffA);
            PG8_WAIT_V(8); PG8_WAIT_L(0); PG8_BAR; PG8_MMA(0, 0, At, B0); PG8_MMA(0, 1, At, B1); PG8_BAR; PG8_SCHED;
            PG8_LDA(At, 0, 1); PG8_STAGE(PG8_SB(0, 0), b2, voffB); PG8_STAGE(PG8_SB(0, 1), b2 + hstep, voffB); PG8_STAGE(PG8_SA(0, 0), a2, voffA);
            PG8_WAIT_V(8); PG8_WAIT_L(0); PG8_BAR; PG8_MMA(1, 0, At, B0); PG8_MMA(1, 1, At, B1); PG8_BAR; PG8_SCHED;
            PG8_LDB(B0, 1, 0); PG8_LDB(B1, 1, 1); PG8_SCHED; PG8_LDA(At, 1, 0); PG8_STAGE(PG8_SA(0, 1), a2 + hstep, voffA);
            PG8_WAIT_V(8); PG8_WAIT_L(0); PG8_BAR; PG8_MMA(0, 0, At, B0); PG8_MMA(0, 1, At, B1); PG8_BAR; PG8_SCHED;
            PG8_LDA(At, 1, 1); PG8_STAGE(PG8_SB(1, 0), b3, voffB); PG8_STAGE(PG8_SB(1, 1), b3 + hstep, voffB); PG8_STAGE(PG8_SA(1, 0), a3, voffA);
            PG8_WAIT_V(8); PG8_WAIT_L(0); PG8_BAR; PG8_MMA(1, 0, At, B0); PG8_MMA(1, 1, At, B1); PG8_BAR; PG8_SCHED;
            } else {
            PG8_LDB(B0, 0, 0); PG8_SCHED; PG8_LDA(At, 0, 0); PG8_STAGE(PG8_SA(1, 1), a1 + hstep, voffA);
            PG8_WAIT_L(8); PG8_BAR; PG8_WAIT_L(0); PG8_MMA(0, 0, At, B0); PG8_BAR; PG8_SCHED;
            PG8_LDB(B1, 0, 1); PG8_STAGE(PG8_SB(0, 0), b2, voffB);
            PG8_BAR; PG8_WAIT_L(0); PG8_MMA(0, 1, At, B1); PG8_BAR;
            PG8_LDA(At, 0, 1); PG8_STAGE(PG8_SA(0, 0), a2, voffA);
            PG8_BAR; PG8_WAIT_L(0); PG8_MMA(1, 0, At, B0); PG8_BAR; PG8_SCHED;
            PG8_STAGE(PG8_SB(0, 1), b2 + hstep, voffB);
            PG8_WAIT_V(6); PG8_BAR; PG8_MMA(1, 1, At, B1); PG8_BAR;
            PG8_LDB(B0, 1, 0); PG8_SCHED; PG8_LDA(At, 1, 0); PG8_STAGE(PG8_SA(0, 1), a2 + hstep, voffA);
            PG8_WAIT_L(8); PG8_BAR; PG8_WAIT_L(0); PG8_MMA(0, 0, At, B0); PG8_BAR; PG8_SCHED;
            PG8_LDB(B1, 1, 1); PG8_STAGE(PG8_SB(1, 0), b3, voffB);
            PG8_BAR; PG8_WAIT_L(0); PG8_MMA(0, 1, At, B1); PG8_BAR;
            PG8_LDA(At, 1, 1); PG8_STAGE(PG8_SA(1, 0), a3, voffA);
            PG8_BAR; PG8_WAIT_L(0); PG8_MMA(1, 0, At, B0); PG8_BAR; PG8_SCHED;
            PG8_STAGE(PG8_SB(1, 1), b3 + hstep, voffB);
            PG8_WAIT_V(6); PG8_BAR; PG8_MMA(1, 1, At, B1); PG8_BAR;
            }
        }
        if constexpr (ALIGN_EPI) { if (wr == 0) PG8_BAR; }
        if constexpr (!Epi::AFTER_DRAIN) { E(acc, cur, wr, wc, fr, fq); S.done(cur); }
        if (!has_next) break;
#pragma unroll
        for (int a = 0; a < 2; ++a)
#pragma unroll
            for (int b = 0; b < 2; ++b)
#pragma unroll
                for (int m = 0; m < 4; ++m)
#pragma unroll
                    for (int n = 0; n < 2; ++n) acc[a][b][m][n] = (f32x4){0.f, 0.f, 0.f, 0.f};
        cur = nxt; cA = nA; cB = nB; ++ui;
        if constexpr (ALIGN_EPI) { if (wr == 1) PG8_BAR; }
    }
    PG8_WAIT_V(0);
    if constexpr (!ALIGN_EPI) { if (wr == 0) PG8_BAR; }
    PG8_BAR;
    if constexpr (Epi::AFTER_DRAIN) { E.fused(acc, cur, wr, wc, fr, fq, lds, wid, lane); S.done(cur); }
#undef PG8_SA
#undef PG8_SB
#undef PG8_STAGE
#undef PG8_LDA
#undef PG8_LDB
#undef PG8_MMA
#undef PG8_WAIT_V
#undef PG8_WAIT_L
#undef PG8_BAR
#undef PG8_SCHED
}
}
namespace pg8 {
struct EpiF32 {
    static constexpr bool PERM = false, AFTER_DRAIN = false;
    float* C; int ldc;
    __device__ __forceinline__ void operator()(const f32x4 (&acc)[2][2][4][2], const Unit& u, int wr, int wc, int fr, int fq) const {
        const int row0 = u.pm * BM + wr * 64 + fr, col0 = u.pn * BM + wc * 32 + 4 * fq;
#pragma unroll
        for (int ai = 0; ai < 2; ++ai)
#pragma unroll
            for (int m = 0; m < 4; ++m) { float* rowp = C + (size_t)(row0 + ai * HALF + m * 16) * ldc + col0;
#pragma unroll
                for (int bj = 0; bj < 2; ++bj)
#pragma unroll
                    for (int n = 0; n < 2; ++n) *(f32x4*)(rowp + bj * HALF + n * 16) = acc[ai][bj][m][n]; }
    }
};
__device__ __forceinline__ float sigmoid_f(float v) { return __builtin_amdgcn_rcpf(1.0f + __builtin_amdgcn_exp2f(-1.4426950408889634f * v)); }
struct EpiSwiGLU {
    static constexpr bool PERM = true, AFTER_DRAIN = false;
    bf16_t* Hh; int ldh;
    __device__ __forceinline__ void operator()(const f32x4 (&acc)[2][2][4][2], const Unit& u, int wr, int wc, int fr, int fq) const {
        const int row0 = u.pm * BM + wr * 64 + fr, col0 = u.pn * HALF + wc * 32 + 8 * fq;
#pragma unroll
        for (int ai = 0; ai < 2; ++ai)
#pragma unroll
            for (int m = 0; m < 4; ++m) { bf16_t* rowp = Hh + (size_t)(row0 + ai * HALF + m * 16) * ldh + col0;
                float h[8];
#pragma unroll
                for (int n = 0; n < 2; ++n)
#pragma unroll
                    for (int e = 0; e < 4; ++e) { const float g = acc[ai][0][m][n][e], up = acc[ai][1][m][n][e]; h[4 * n + e] = g * sigmoid_f(g) * up; }
                u32x4 w; w.x = cvt_pk_bf16(h[0], h[1]); w.y = cvt_pk_bf16(h[2], h[3]); w.z = cvt_pk_bf16(h[4], h[5]); w.w = cvt_pk_bf16(h[6], h[7]);
                *(u32x4*)rowp = w; }
    }
};
__device__ __forceinline__ float bf_lo(unsigned w) { return __builtin_bit_cast(float, w << 16); }
__device__ __forceinline__ float bf_hi(unsigned w) { return __builtin_bit_cast(float, w & 0xffff0000u); }
struct EpiGlu {
    static constexpr bool PERM = true, AFTER_DRAIN = false;
    const bf16_t* Y; bf16_t* Z; int ldc;
    __device__ __forceinline__ void operator()(const f32x4 (&acc)[2][2][4][2], const Unit& u, int wr, int wc, int fr, int fq) const {
        const int row0 = u.pm * BM + wr * 64 + fr, col0 = u.pn * BM + wc * 32 + 8 * fq;
#pragma unroll
        for (int ai = 0; ai < 2; ++ai)
#pragma unroll
            for (int m = 0; m < 4; ++m) { const size_t off = (size_t)(row0 + ai * HALF + m * 16) * ldc + col0;
#pragma unroll
                for (int bj = 0; bj < 2; ++bj) { const u32x4 y = *(const u32x4*)(Y + off + bj * HALF); const f32x4 a0 = acc[ai][bj][m][0], a1 = acc[ai][bj][m][1];
                    u32x4 w;
                    w.x = cvt_pk_bf16(bf_lo(y.x) * sigmoid_f(a0[0]), bf_hi(y.x) * sigmoid_f(a0[1]));
                    w.y = cvt_pk_bf16(bf_lo(y.y) * sigmoid_f(a0[2]), bf_hi(y.y) * sigmoid_f(a0[3]));
                    w.z = cvt_pk_bf16(bf_lo(y.z) * sigmoid_f(a1[0]), bf_hi(y.z) * sigmoid_f(a1[1]));
                    w.w = cvt_pk_bf16(bf_lo(y.w) * sigmoid_f(a1[2]), bf_hi(y.w) * sigmoid_f(a1[3]));
                    *(u32x4*)(Z + off + bj * HALF) = w; } }
    }
};
}
#ifndef PG8_SP2
#define PG8_SP2 true
#endif
#ifndef PG8_ALIGN
#define PG8_ALIGN true
#endif
#ifndef MK_ONE_LAUNCH
#define MK_ONE_LAUNCH 0
#endif
constexpr int NWAVES = 8;
constexpr int BATCH = 16, SEQ = 2048, D = 1024, NH = 16, HD = 64, FF = 2816, M = BATCH * SEQ;
constexpr int NFOX = 4 * D + NH;
constexpr int NG = 64, NP = 64, GC = 16;
constexpr float EPS = 1e-6f;
constexpr float LOG2E = 1.4426950408889634f;
constexpr float C2 = 0.125f * LOG2E;
constexpr size_t MiB = 1u << 20;
constexpr size_t WS_CTL = 0, CTL_ZERO_BYTES = 1 * MiB;
constexpr size_t WS_WFOX = 2 * MiB;
constexpr size_t WS_WF = 10 * MiB;
constexpr size_t WS_WFO = 11 * MiB, WS_WSI = 13 * MiB, WS_WSG = 15 * MiB, WS_WSO = 17 * MiB;
constexpr size_t WS_WGU0 = 19 * MiB, WS_WD0 = 30 * MiB, WS_WGU1 = 36 * MiB, WS_WD1 = 47 * MiB;
constexpr size_t WS_LOGF = 54 * MiB;
constexpr size_t WS_XCH = 56 * MiB;
constexpr size_t WS_XN = 64 * MiB;
constexpr size_t WS_Q = 128 * MiB, WS_K = 192 * MiB, WS_V = 256 * MiB, WS_GT = 320 * MiB;
constexpr size_t WS_H = 128 * MiB;
constexpr size_t WS_U = 128 * MiB, WS_Y = 192 * MiB, WS_Z = 256 * MiB;
constexpr size_t WS_SCR = 320 * MiB;
constexpr size_t WS_END = 448 * MiB;
constexpr int CW_TMO = 0, CW_CODE = 1, CW_BAR = 4096;
constexpr int RING_OFF = 0, RING_BYTES = 131072;
constexpr int LDSCTL_OFF = RING_BYTES, MISC_OFF = LDSCTL_OFF + 320;
constexpr int LDS_BYTES = 147456;
#define GAS __attribute__((address_space(1)))
#define LAS __attribute__((address_space(3)))
typedef unsigned short bf16;
typedef unsigned v4u __attribute__((ext_vector_type(4)));
typedef float f32x4 __attribute__((ext_vector_type(4)));
typedef GAS unsigned gu32;
#define RLX_AGENT __ATOMIC_RELAXED, __HIP_MEMORY_SCOPE_AGENT
#define LDS_WAIT() asm volatile("s_waitcnt lgkmcnt(0)" ::: "memory")
#define VM_WAIT() asm volatile("s_waitcnt vmcnt(0)" ::: "memory")
__device__ __forceinline__ unsigned f2bf(float f) { unsigned u = __builtin_bit_cast(unsigned, f); return (u + 0x7fffu + ((u >> 16) & 1u)) >> 16; }
__device__ __forceinline__ unsigned pk2(float lo, float hi) { return f2bf(lo) | (f2bf(hi) << 16); }
__device__ __forceinline__ float bflo(unsigned w) { return __builtin_bit_cast(float, w << 16); }
__device__ __forceinline__ float bfhi(unsigned w) { return __builtin_bit_cast(float, w & 0xffff0000u); }
__device__ __forceinline__ float sigm(float v) { return __builtin_amdgcn_rcpf(1.0f + __builtin_amdgcn_exp2f(-LOG2E * v)); }

#define XB_TMO      128
#define XB_XCNT(j)  (256  + 64 * (j))
#define XB_XSUB(j)  (1280 + 64 * (j))
#define XB_XGEN(j)  (2304 + 64 * (j))
#define XB_TOP      3328
#define XB_TOPGEN   3392
#define XCD_BAR_WORDS 3456
#define XB_SPIN_CAP (1u << 18)
__device__ __forceinline__ unsigned xb_ld(unsigned* p)              { return __hip_atomic_load(p, __ATOMIC_RELAXED, __HIP_MEMORY_SCOPE_AGENT); }
__device__ __forceinline__ unsigned xb_add(unsigned* p, unsigned v) { return __hip_atomic_fetch_add(p, v, __ATOMIC_RELAXED, __HIP_MEMORY_SCOPE_AGENT); }
__device__ __forceinline__ unsigned xb_xcc_id() { return (unsigned)__builtin_amdgcn_s_getreg((3 << 11) | 20) & 0xFu; }
#define XB_SPIN(cond, bar) do { unsigned _sp = 0; while (cond) { __builtin_amdgcn_s_sleep(1); \
    if ((++_sp & 255u) == 0u) { if (xb_ld(&(bar)[XB_TMO])) break; if (_sp > XB_SPIN_CAP) { atomicAdd(&(bar)[XB_TMO], 1u); break; } } } } while (0)
struct XcdBarrier { unsigned* bar; unsigned x; volatile LAS unsigned* st; };
__device__ __forceinline__ XcdBarrier xcd_barrier_post(unsigned* bar, volatile LAS unsigned* st) {
    XcdBarrier b; b.bar = bar; b.x = xb_xcc_id(); b.st = st;
    if (threadIdx.x == 0) (void)xb_add(&bar[XB_XCNT(b.x)], 1u);
    return b;
}
__device__ __forceinline__ void xcd_barrier_complete(unsigned* bar, unsigned x, unsigned& nloc, unsigned& nx) {
    const unsigned G = gridDim.x * gridDim.y * gridDim.z;
    unsigned sum, cnt, mine, sp = 0u;
    for (;;) {
        sum = 0u; cnt = 0u; mine = 0u;
#pragma unroll
        for (unsigned j = 0; j < 16; ++j) { const unsigned c = xb_ld(&bar[XB_XCNT(j)]); sum += c; cnt += (c > 0u) ? 1u : 0u; mine = (j == x) ? c : mine; }
        if (sum == G) break;
        __builtin_amdgcn_s_sleep(1);
        if ((++sp & 255u) == 0u) { if (xb_ld(&bar[XB_TMO])) break; if (sp > XB_SPIN_CAP) { atomicAdd(&bar[XB_TMO], 1u); break; } }
    }
    nloc = mine > 0u ? mine : 1u; nx = cnt > 0u ? cnt : 1u;
}
__device__ __forceinline__ void xcd_barrier(const XcdBarrier& b) {
    asm volatile("s_waitcnt vmcnt(0)" ::: "memory");
    __syncthreads();
    if (threadIdx.x == 0) {
        unsigned* bar = b.bar;
        __builtin_amdgcn_s_waitcnt(0);
        unsigned nloc = b.st[0], nx = b.st[1];
        if (nloc == 0u) { xcd_barrier_complete(bar, b.x, nloc, nx); b.st[0] = nloc; b.st[1] = nx; }
        const unsigned old = xb_add(&bar[XB_XSUB(b.x)], 1u);
        const unsigned gen = old / nloc;
        if (old + 1u == (gen + 1u) * nloc) {
            __builtin_amdgcn_fence(__ATOMIC_RELEASE, "agent");
            asm volatile("s_waitcnt vmcnt(0)" ::: "memory");
            const unsigned og = xb_add(&bar[XB_TOP], 1u);
            const unsigned tg = og / nx;
            if (og + 1u == (tg + 1u) * nx) xb_add(&bar[XB_TOPGEN], 1u);
            else XB_SPIN(xb_ld(&bar[XB_TOPGEN]) == tg, bar);
            __builtin_amdgcn_fence(__ATOMIC_ACQUIRE, "agent");
            xb_add(&bar[XB_XGEN(b.x)], 1u);
            asm volatile("s_waitcnt vmcnt(0)" ::: "memory");
        } else {
            XB_SPIN(xb_ld(&bar[XB_XGEN(b.x)]) == gen, bar);
            __builtin_amdgcn_fence(__ATOMIC_ACQUIRE, "agent");
            asm volatile("s_waitcnt vmcnt(0)" ::: "memory");
        }
    }
    __syncthreads();
}

struct Args { const float* in[24]; float* out; unsigned char* ws; int ph_lo, ph_hi; };
struct Frame {
    LAS unsigned char* lds;
    volatile LAS unsigned* MISC;
    gu32* ctl;
    int tid, lane, wave, vcu, G;
    unsigned char* ws;
    float* out;
};
__device__ __forceinline__ float wave_sum(float v) {
#pragma unroll
    for (int o = 1; o < 64; o <<= 1) v += __shfl_xor(v, o);
    return v;
}
__device__ __forceinline__ void transpose_item(const float* W, int ldw, const float* gain, bf16* WT, int K, int k0, int n0, int drow0, LAS float* scr, int lane) {
#pragma unroll 8
    for (int i = 0; i < 32; ++i) { const int kk = 2 * i + (lane >> 5); const float g = gain ? gain[k0 + kk] : 1.f; scr[kk * 33 + (lane & 31)] = W[(size_t)(k0 + kk) * ldw + n0 + (lane & 31)] * g; }
    LDS_WAIT(); asm volatile("" ::: "memory");
    const int c = lane & 7;
#pragma unroll
    for (int j = 0; j < 4; ++j) { const int n = (lane >> 3) + 8 * j; const LAS float* s = scr + (8 * c) * 33 + n;
        v4u o; o.x = pk2(s[0 * 33], s[1 * 33]); o.y = pk2(s[2 * 33], s[3 * 33]); o.z = pk2(s[4 * 33], s[5 * 33]); o.w = pk2(s[6 * 33], s[7 * 33]);
        *(GAS v4u*)(WT + (size_t)(drow0 + n) * K + k0 + 8 * c) = o; }
    LDS_WAIT(); asm volatile("" ::: "memory");
}
__device__ __forceinline__ void rms_row_to_bf16(const float* xrow, bf16* orow, int lane) {
    const GAS f32x4* xr = (const GAS f32x4*)xrow + lane;
    f32x4 v[4]; float s = 0.f;
#pragma unroll
    for (int j = 0; j < 4; ++j) { v[j] = xr[64 * j]; s += (v[j].x * v[j].x + v[j].y * v[j].y) + (v[j].z * v[j].z + v[j].w * v[j].w); }
    const float r = 1.0f / sqrtf(wave_sum(s) * (1.f / D) + EPS);
    GAS unsigned long long* o8 = (GAS unsigned long long*)orow + lane;
#pragma unroll
    for (int j = 0; j < 4; ++j) o8[64 * j] = (unsigned long long)pk2(v[j].x * r, v[j].y * r) | ((unsigned long long)pk2(v[j].z * r, v[j].w * r) << 32);
}
__device__ __forceinline__ void p0_prologue(Frame& F, const Args& A) {
    LAS float* scr = (LAS float*)(F.lds + RING_OFF + F.wave * 16384);
    const int gw = F.vcu * NWAVES + F.wave, NGW = F.G * NWAVES;
    constexpr int I_FOX = 16 * 128, I_SQ = 16 * 32, I_FF = 16 * 88, I_DN = 44 * 32;
    constexpr int NITEMS = I_FOX + 4 * I_SQ + 4 * I_FF + 2 * I_DN;
    unsigned char* ws = F.ws;
    for (int it = gw; it < NITEMS; it += NGW) {
        int r = it; const float* W; int ldw; const float* gain; bf16* WT; int K, N, mode;
        if (r < I_FOX) { W = A.in[1]; ldw = NFOX; gain = A.in[17]; WT = (bf16*)(ws + WS_WFOX); K = D; N = 4 * D; mode = 0; }
        else if ((r -= I_FOX) < I_SQ) { W = A.in[5]; ldw = D; gain = nullptr; WT = (bf16*)(ws + WS_WFO); K = D; N = D; mode = 0; }
        else if ((r -= I_SQ) < I_SQ) { W = A.in[6]; ldw = D; gain = A.in[17] + D; WT = (bf16*)(ws + WS_WSI); K = D; N = D; mode = 0; }
        else if ((r -= I_SQ) < I_SQ) { W = A.in[15]; ldw = D; gain = nullptr; WT = (bf16*)(ws + WS_WSG); K = D; N = D; mode = 0; }
        else if ((r -= I_SQ) < I_SQ) { W = A.in[16]; ldw = D; gain = nullptr; WT = (bf16*)(ws + WS_WSO); K = D; N = D; mode = 0; }
        else if ((r -= I_SQ) < I_FF) { W = A.in[21]; ldw = FF; gain = A.in[19]; WT = (bf16*)(ws + WS_WGU0); K = D; N = FF; mode = 1; }
        else if ((r -= I_FF) < I_FF) { W = A.in[22]; ldw = FF; gain = A.in[19]; WT = (bf16*)(ws + WS_WGU0); K = D; N = FF; mode = 2; }
        else if ((r -= I_FF) < I_DN) { W = A.in[23]; ldw = D; gain = nullptr; WT = (bf16*)(ws + WS_WD0); K = FF; N = D; mode = 0; }
        else if ((r -= I_DN) < I_FF) { W = A.in[21] + (size_t)D * FF; ldw = FF; gain = A.in[19] + D; WT = (bf16*)(ws + WS_WGU1); K = D; N = FF; mode = 1; }
        else if ((r -= I_FF) < I_FF) { W = A.in[22] + (size_t)D * FF; ldw = FF; gain = A.in[19] + D; WT = (bf16*)(ws + WS_WGU1); K = D; N = FF; mode = 2; }
        else { r -= I_FF; W = A.in[23] + (size_t)FF * D; ldw = D; gain = nullptr; WT = (bf16*)(ws + WS_WD1); K = FF; N = D; mode = 0; }
        const int nnb = N / 32, kb = r / nnb, nb = r % nnb, k0 = 64 * kb, n0 = 32 * nb;
        const int drow0 = (mode == 0) ? n0 : (256 * (n0 / 128) + (n0 % 128) + (mode == 2 ? 128 : 0));
        transpose_item(W, ldw, gain, WT, K, k0, n0, drow0, scr, F.lane);
    }
    {
        const int gt = gw * 64 + F.lane, NT = NGW * 64; bf16* WF = (bf16*)(ws + WS_WF);
        for (int e = gt; e < NH * D; e += NT) { const int h = e & 15, k = e >> 4; WF[h * D + k] = (bf16)f2bf(A.in[1][(size_t)k * NFOX + 4 * D + h] * A.in[17][k]); }
    }
    bf16* XN = (bf16*)(ws + WS_XN);
    for (int m = gw; m < M; m += NGW) rms_row_to_bf16(A.in[0] + (size_t)m * D, XN + (size_t)m * D, F.lane);
}
__device__ __forceinline__ void nr_pass(Frame& F, const float* acc, const float* xin, const float* gain, float* xout, bf16* xn) {
    const int gw = F.vcu * NWAVES + F.wave, NGW = F.G * NWAVES;
    for (int m = gw; m < M; m += NGW) {
        const GAS f32x4* ar = (const GAS f32x4*)(acc + (size_t)m * D) + F.lane; const GAS f32x4* xr = (const GAS f32x4*)(xin + (size_t)m * D) + F.lane;
        const GAS f32x4* gr = (const GAS f32x4*)gain + F.lane; GAS f32x4* orow = (GAS f32x4*)(xout + (size_t)m * D) + F.lane;
        f32x4 a[4], x[4]; float s = 0.f;
#pragma unroll
        for (int j = 0; j < 4; ++j) { a[j] = ar[64 * j]; x[j] = xr[64 * j]; s += (a[j].x * a[j].x + a[j].y * a[j].y) + (a[j].z * a[j].z + a[j].w * a[j].w); }
        const float r = 1.0f / sqrtf(wave_sum(s) * (1.f / D) + EPS); float s2 = 0.f;
#pragma unroll
        for (int j = 0; j < 4; ++j) { x[j] = x[j] + a[j] * r * gr[64 * j]; orow[64 * j] = x[j]; s2 += (x[j].x * x[j].x + x[j].y * x[j].y) + (x[j].z * x[j].z + x[j].w * x[j].w); }
        if (xn) { const float r2 = 1.0f / sqrtf(wave_sum(s2) * (1.f / D) + EPS);
            GAS unsigned long long* o8 = (GAS unsigned long long*)(xn + (size_t)m * D) + F.lane;
#pragma unroll
            for (int j = 0; j < 4; ++j) o8[64 * j] = (unsigned long long)pk2(x[j].x * r2, x[j].y * r2) | ((unsigned long long)pk2(x[j].z * r2, x[j].w * r2) << 32); }
    }
}
__device__ __forceinline__ float log_sigmoid_f(float z) {
    const float e = __expf(-fabsf(z));
    const float l1p = (e < 0.01f) ? e * (1.f - e * (0.5f - e * 0.33333333f)) : __logf(1.f + e);
    return fminf(z, 0.f) - l1p;
}
__device__ __forceinline__ void flog_naive(Frame& F, const float* b_f) {
    const int gw = F.vcu * NWAVES + F.wave, NGW = F.G * NWAVES;
    const bf16* XN = (const bf16*)(F.ws + WS_XN); const bf16* WF = (const bf16*)(F.ws + WS_WF); float* LOGF = (float*)(F.ws + WS_LOGF);
    for (int m = gw; m < M; m += NGW) {
        const GAS v4u* xr = (const GAS v4u*)(XN + (size_t)m * D) + 2 * F.lane; const v4u x0 = xr[0], x1 = xr[1];
        float xv[16];
        xv[0] = bflo(x0.x); xv[1] = bfhi(x0.x); xv[2] = bflo(x0.y); xv[3] = bfhi(x0.y); xv[4] = bflo(x0.z); xv[5] = bfhi(x0.z); xv[6] = bflo(x0.w); xv[7] = bfhi(x0.w);
        xv[8] = bflo(x1.x); xv[9] = bfhi(x1.x); xv[10] = bflo(x1.y); xv[11] = bfhi(x1.y); xv[12] = bflo(x1.z); xv[13] = bfhi(x1.z); xv[14] = bflo(x1.w); xv[15] = bfhi(x1.w);
        float mine = 0.f;
#pragma unroll
        for (int h = 0; h < NH; ++h) { const GAS v4u* wr = (const GAS v4u*)(WF + (size_t)h * D) + 2 * F.lane; const v4u w0 = wr[0], w1 = wr[1];
            float p = xv[0] * bflo(w0.x) + xv[1] * bfhi(w0.x) + xv[2] * bflo(w0.y) + xv[3] * bfhi(w0.y) + xv[4] * bflo(w0.z) + xv[5] * bfhi(w0.z) + xv[6] * bflo(w0.w) + xv[7] * bfhi(w0.w)
                    + xv[8] * bflo(w1.x) + xv[9] * bfhi(w1.x) + xv[10] * bflo(w1.y) + xv[11] * bfhi(w1.y) + xv[12] * bflo(w1.z) + xv[13] * bfhi(w1.z) + xv[14] * bflo(w1.w) + xv[15] * bfhi(w1.w);
            p = wave_sum(p); if (F.lane == h) mine = p; }
        if (F.lane < NH) LOGF[(size_t)m * NH + F.lane] = log_sigmoid_f(mine + b_f[F.lane]);
    }
}
__device__ __forceinline__ void headnorm_naive(Frame& F, const float* qg, const float* kg) {
    const int gw = F.vcu * NWAVES + F.wave, NGW = F.G * NWAVES;
    for (int it = gw; it < 2 * M; it += NGW) {
        const int which = it >= M ? 1 : 0, row = it - which * M;
        bf16* base = (bf16*)(F.ws + (which ? WS_K : WS_Q)) + (size_t)row * D; const float* gn = which ? kg : qg;
        GAS v4u* p = (GAS v4u*)base + 2 * F.lane; const v4u x0 = p[0], x1 = p[1];
        float v[16];
        v[0] = bflo(x0.x); v[1] = bfhi(x0.x); v[2] = bflo(x0.y); v[3] = bfhi(x0.y); v[4] = bflo(x0.z); v[5] = bfhi(x0.z); v[6] = bflo(x0.w); v[7] = bfhi(x0.w);
        v[8] = bflo(x1.x); v[9] = bfhi(x1.x); v[10] = bflo(x1.y); v[11] = bfhi(x1.y); v[12] = bflo(x1.z); v[13] = bfhi(x1.z); v[14] = bflo(x1.w); v[15] = bfhi(x1.w);
        float s = 0.f;
#pragma unroll
        for (int i = 0; i < 16; ++i) s += v[i] * v[i];
        s += __shfl_xor(s, 1); s += __shfl_xor(s, 2);
        float r = 1.0f / sqrtf(s * (1.f / HD) + EPS); if (!which) r *= C2;
        const int d0 = 16 * (F.lane & 3);
#pragma unroll
        for (int i = 0; i < 16; ++i) v[i] = v[i] * r * gn[d0 + i];
        v4u o0, o1; o0.x = pk2(v[0], v[1]); o0.y = pk2(v[2], v[3]); o0.z = pk2(v[4], v[5]); o0.w = pk2(v[6], v[7]);
        o1.x = pk2(v[8], v[9]); o1.y = pk2(v[10], v[11]); o1.z = pk2(v[12], v[13]); o1.w = pk2(v[14], v[15]);
        p[0] = o0; p[1] = o1;
    }
}
__device__ __forceinline__ void attn_naive(Frame& F) {
    LAS float* bias2 = (LAS float*)(F.lds);
    LAS unsigned char* Kt = F.lds + 8192; LAS unsigned char* Vt = F.lds + 16384; LAS float* wtot = (LAS float*)(F.lds + 24576);
    const float* LOGF = (const float*)(F.ws + WS_LOGF);
    const bf16* Qb = (const bf16*)(F.ws + WS_Q); const bf16* Kb = (const bf16*)(F.ws + WS_K); const bf16* Vb = (const bf16*)(F.ws + WS_V); const bf16* Gb = (const bf16*)(F.ws + WS_GT);
    bf16* Ob = (bf16*)(F.ws + WS_Q);
    for (int bh = F.vcu; bh < BATCH * NH; bh += F.G) {
        const int b = bh / NH, h = bh % NH;
        __syncthreads();
        {   const int t0 = 4 * F.tid; float lf0, lf1, lf2, lf3;
            lf0 = LOGF[((size_t)b * SEQ + t0 + 0) * NH + h]; lf1 = LOGF[((size_t)b * SEQ + t0 + 1) * NH + h]; lf2 = LOGF[((size_t)b * SEQ + t0 + 2) * NH + h]; lf3 = LOGF[((size_t)b * SEQ + t0 + 3) * NH + h];
            const float s1 = lf0 + lf1, s2 = s1 + lf2, s3 = s2 + lf3; float inc = s3;
#pragma unroll
            for (int o = 1; o < 64; o <<= 1) { const float v = __shfl_up(inc, o); if (F.lane >= o) inc += v; }
            if (F.lane == 63) wtot[F.wave] = inc;
            __syncthreads();
            float woff = 0.f; for (int w = 0; w < F.wave; ++w) woff += wtot[w];
            const float ex = inc - s3 + woff;
            bias2[t0] = -(ex + lf0) * LOG2E; bias2[t0 + 1] = -(ex + s1) * LOG2E; bias2[t0 + 2] = -(ex + s2) * LOG2E; bias2[t0 + 3] = -(ex + s3) * LOG2E;
        }
        __syncthreads();
        for (int qblk = 0; qblk < 4; ++qblk) {
            const int q = 512 * qblk + F.tid; const size_t R = (size_t)b * SEQ + q;
            float qv[64], o[64];
#pragma unroll
            for (int ch = 0; ch < 8; ++ch) { const v4u w = *(const GAS v4u*)(Qb + R * D + h * HD + 8 * ch);
                qv[8 * ch] = bflo(w.x); qv[8 * ch + 1] = bfhi(w.x); qv[8 * ch + 2] = bflo(w.y); qv[8 * ch + 3] = bfhi(w.y); qv[8 * ch + 4] = bflo(w.z); qv[8 * ch + 5] = bfhi(w.z); qv[8 * ch + 6] = bflo(w.w); qv[8 * ch + 7] = bfhi(w.w); }
#pragma unroll
            for (int d = 0; d < 64; ++d) o[d] = 0.f;
            float mx = -INFINITY, l = 0.f;
            const int ntile = 8 * (qblk + 1);
            for (int jt = 0; jt < ntile; ++jt) {
                __syncthreads();
                {   const int j = F.tid >> 3, ch = F.tid & 7; const size_t src = ((size_t)b * SEQ + 64 * jt + j) * D + h * HD + 8 * ch;
                    *(LAS v4u*)(Kt + j * 128 + ch * 16) = *(const GAS v4u*)(Kb + src); *(LAS v4u*)(Vt + j * 128 + ch * 16) = *(const GAS v4u*)(Vb + src); }
                __syncthreads();
                for (int j = 0; j < 64; ++j) {
                    const int s = 64 * jt + j;
                    if (s <= q) {
                        float dot = 0.f;
#pragma unroll
                        for (int ch = 0; ch < 8; ++ch) { const v4u w = *(const LAS v4u*)(Kt + j * 128 + ch * 16);
                            dot += qv[8 * ch] * bflo(w.x) + qv[8 * ch + 1] * bfhi(w.x) + qv[8 * ch + 2] * bflo(w.y) + qv[8 * ch + 3] * bfhi(w.y) + qv[8 * ch + 4] * bflo(w.z) + qv[8 * ch + 5] * bfhi(w.z) + qv[8 * ch + 6] * bflo(w.w) + qv[8 * ch + 7] * bfhi(w.w); }
                        const float sv = dot + bias2[s];
                        if (sv > mx) { const float al = __builtin_amdgcn_exp2f(mx - sv); l *= al;
#pragma unroll
                            for (int d = 0; d < 64; ++d) o[d] *= al;
                            mx = sv; }
                        const float p = __builtin_amdgcn_exp2f(sv - mx); l += p;
#pragma unroll
                        for (int ch = 0; ch < 8; ++ch) { const v4u w = *(const LAS v4u*)(Vt + j * 128 + ch * 16);
                            o[8 * ch] += p * bflo(w.x); o[8 * ch + 1] += p * bfhi(w.x); o[8 * ch + 2] += p * bflo(w.y); o[8 * ch + 3] += p * bfhi(w.y); o[8 * ch + 4] += p * bflo(w.z); o[8 * ch + 5] += p * bfhi(w.z); o[8 * ch + 6] += p * bflo(w.w); o[8 * ch + 7] += p * bfhi(w.w); }
                    }
                }
            }
            const float il = 1.0f / l;
#pragma unroll
            for (int ch = 0; ch < 8; ++ch) { const v4u g = *(const GAS v4u*)(Gb + R * D + h * HD + 8 * ch); v4u w;
                w.x = pk2(o[8 * ch] * il * sigm(bflo(g.x)), o[8 * ch + 1] * il * sigm(bfhi(g.x))); w.y = pk2(o[8 * ch + 2] * il * sigm(bflo(g.y)), o[8 * ch + 3] * il * sigm(bfhi(g.y)));
                w.z = pk2(o[8 * ch + 4] * il * sigm(bflo(g.z)), o[8 * ch + 5] * il * sigm(bfhi(g.z))); w.w = pk2(o[8 * ch + 6] * il * sigm(bflo(g.w)), o[8 * ch + 7] * il * sigm(bfhi(g.w)));
                *(GAS v4u*)(Ob + R * D + h * HD + 8 * ch) = w; }
        }
    }
}
__device__ __forceinline__ float gelu_tanh(float v) { return v * sigm(1.5957691216f * (v + 0.044715f * v * v * v)); }
__device__ __forceinline__ void s5_naive(Frame& F, const Args& A) {
    const int gw = F.vcu * NWAVES + F.wave, NGW = F.G * NWAVES;
    const bf16* U = (const bf16*)(F.ws + WS_U); bf16* Y = (bf16*)(F.ws + WS_Y);
    for (int item = gw; item < BATCH * NG; item += NGW) {
        const int b = item / NG, g = item % NG, p = F.lane;
        const float dt = __expf(A.in[7][g]);
        const float lr = A.in[8][g * NP + p], li = A.in[9][g * NP + p];
        const float mag = __expf(lr * dt);
        float rev = li * dt * 0.15915494309189535f; rev -= floorf(rev);
        const float a_re = mag * __builtin_amdgcn_cosf(rev), a_im = mag * __builtin_amdgcn_sinf(rev);
        const float den = lr * lr + li * li, nre = a_re - 1.f;
        const float z_re = (nre * lr + a_im * li) / den, z_im = (a_im * lr - nre * li) / den;
        float bbr[16], bbi[16], cr[16], ci[16];
#pragma unroll
        for (int c = 0; c < GC; ++c) { const float br = A.in[10][(size_t)(g * NP + p) * GC + c], bi = A.in[11][(size_t)(g * NP + p) * GC + c];
            bbr[c] = z_re * br - z_im * bi; bbi[c] = z_re * bi + z_im * br;
            cr[c] = A.in[12][(size_t)(g * GC + c) * NP + p]; ci[c] = A.in[13][(size_t)(g * GC + c) * NP + p]; }
        const int cw = (F.lane >> 2) & 15;
        const float dsk = A.in[14][g * GC + cw];
        float xr = 0.f, xi = 0.f;
        const bf16* up = U + (size_t)b * SEQ * D + g * GC; bf16* yp = Y + (size_t)b * SEQ * D + g * GC;
        v4u u0 = *(const GAS v4u*)up, u1 = *(const GAS v4u*)(up + 8); unsigned us = up[cw];
        for (int t = 0; t < SEQ; ++t) {
            const v4u c0 = u0, c1 = u1; const unsigned cs = us;
            if (t + 1 < SEQ) { u0 = *(const GAS v4u*)(up + (size_t)(t + 1) * D); u1 = *(const GAS v4u*)(up + (size_t)(t + 1) * D + 8); us = up[(size_t)(t + 1) * D + cw]; }
            float uv[16];
            uv[0] = bflo(c0.x); uv[1] = bfhi(c0.x); uv[2] = bflo(c0.y); uv[3] = bfhi(c0.y); uv[4] = bflo(c0.z); uv[5] = bfhi(c0.z); uv[6] = bflo(c0.w); uv[7] = bfhi(c0.w);
            uv[8] = bflo(c1.x); uv[9] = bfhi(c1.x); uv[10] = bflo(c1.y); uv[11] = bfhi(c1.y); uv[12] = bflo(c1.z); uv[13] = bfhi(c1.z); uv[14] = bflo(c1.w); uv[15] = bfhi(c1.w);
            float bur = 0.f, bui = 0.f;
#pragma unroll
            for (int c = 0; c < GC; ++c) { bur += bbr[c] * uv[c]; bui += bbi[c] * uv[c]; }
            const float nxr = a_re * xr - a_im * xi + bur, nxi = a_re * xi + a_im * xr + bui; xr = nxr; xi = nxi;
            float y[16];
#pragma unroll
            for (int c = 0; c < GC; ++c) y[c] = cr[c] * xr - ci[c] * xi;
            const bool b5 = (F.lane & 32) != 0, b4 = (F.lane & 16) != 0, b3 = (F.lane & 8) != 0, b2 = (F.lane & 4) != 0;
            float w8[8], w4[4], w2[2];
#pragma unroll
            for (int i = 0; i < 8; ++i) { const float send = b5 ? y[i] : y[i + 8], keep = b5 ? y[i + 8] : y[i]; w8[i] = keep + __shfl_xor(send, 32); }
#pragma unroll
            for (int i = 0; i < 4; ++i) { const float send = b4 ? w8[i] : w8[i + 4], keep = b4 ? w8[i + 4] : w8[i]; w4[i] = keep + __shfl_xor(send, 16); }
#pragma unroll
            for (int i = 0; i < 2; ++i) { const float send = b3 ? w4[i] : w4[i + 2], keep = b3 ? w4[i + 2] : w4[i]; w2[i] = keep + __shfl_xor(send, 8); }
            float w1; { const float send = b2 ? w2[0] : w2[1], keep = b2 ? w2[1] : w2[0]; w1 = keep + __shfl_xor(send, 4); }
            w1 += __shfl_xor(w1, 2); w1 += __shfl_xor(w1, 1);
            if ((F.lane & 3) == 0) { const float v = w1 + dsk * __builtin_bit_cast(float, cs << 16); yp[(size_t)t * D + cw] = (bf16)f2bf(gelu_tanh(v)); }
        }
    }
}

constexpr int NPH = 18;
typedef const __attribute__((address_space(4))) Args* KArgs;
template <class Epi, int N_, int K_>
__device__ __forceinline__ void run_gemm(Frame& F, const bf16* A, const bf16* Bt, const Epi& E) {
    pg8::Gemm g{A, Bt, M, N_, K_}; pg8::StaticOrder S; S.init(M, N_, F.G, (int)blockIdx.x);
    pg8::gemm_phase<Epi, pg8::StaticOrder, PG8_ALIGN, PG8_SP2>(F.lds + RING_OFF, g, S, E);
}
__global__ void __launch_bounds__(NWAVES * 64, 2) mk_fwd(Args args_unused) {
    extern __shared__ __attribute__((aligned(16))) unsigned char lds[];
    const KArgs kp0 = (KArgs)__builtin_amdgcn_kernarg_segment_ptr();
    Frame F;
    F.lds = (LAS unsigned char*)lds;
    F.MISC = (volatile LAS unsigned*)(F.lds + MISC_OFF);
    F.tid = threadIdx.x; F.lane = F.tid & 63; F.wave = __builtin_amdgcn_readfirstlane(F.tid >> 6);
    F.G = gridDim.x; { const int bx = blockIdx.x; F.vcu = (F.G % 8 == 0) ? (bx % 8) * (F.G / 8) + bx / 8 : bx; }
    F.ws = kp0->ws; F.out = kp0->out;
    F.ctl = (gu32*)(F.ws + WS_CTL);
    for (int u = F.tid; u < (LDS_BYTES - LDSCTL_OFF) / 4; u += NWAVES * 64) ((LAS unsigned*)(F.lds + LDSCTL_OFF))[u] = 0u;
    __syncthreads();
    const int lo = kp0->ph_lo, hi = kp0->ph_hi;
    XcdBarrier bar; bar.bar = (unsigned*)(F.ctl + CW_BAR); bar.x = 0; bar.st = nullptr;
    if (hi - lo > 1) bar = xcd_barrier_post((unsigned*)(F.ctl + CW_BAR), F.MISC + 8);
#define IN(k) (lo <= (k) && (k) < hi)
#define SEAM(k) do { if (IN(k) && IN((k) + 1)) xcd_barrier(bar); } while (0)
#define PHASE(k) if (IN(k)) { KArgs ap = kp0; asm volatile("" : "+s"(ap)); unsigned char* ws = ap->ws; F.ws = ws; F.out = ap->out; (void)ws;
#define ENDPHASE(k) } SEAM(k);
    PHASE(0) { Args a; for (int i = 0; i < 24; ++i) a.in[i] = ap->in[i]; a.out = ap->out; a.ws = ws; a.ph_lo = 0; a.ph_hi = 0; p0_prologue(F, a); } ENDPHASE(0)
    PHASE(1) flog_naive(F, ap->in[2]); ENDPHASE(1)
    PHASE(2) { pg8::EpiBf16<0> E{(bf16*)(ws + WS_Q), D, nullptr, D, (size_t)(WS_K - WS_Q) / 2, 1.0f};
               run_gemm<pg8::EpiBf16<0>, 4 * D, D>(F, (const bf16*)(ws + WS_XN), (const bf16*)(ws + WS_WFOX), E); } ENDPHASE(2)
    PHASE(3) headnorm_naive(F, ap->in[3], ap->in[4]); ENDPHASE(3)
    PHASE(4) attn_naive(F); ENDPHASE(4)
    PHASE(5) { pg8::EpiF32 E{(float*)(ws + WS_SCR), D}; run_gemm<pg8::EpiF32, D, D>(F, (const bf16*)(ws + WS_Q), (const bf16*)(ws + WS_WFO), E); } ENDPHASE(5)
    PHASE(6) nr_pass(F, (const float*)(ws + WS_SCR), ap->in[0], ap->in[18], ap->out, (bf16*)(ws + WS_XN)); ENDPHASE(6)
    PHASE(7) { pg8::EpiSwiGLU E{(bf16*)(ws + WS_H), FF}; run_gemm<pg8::EpiSwiGLU, 2 * FF, D>(F, (const bf16*)(ws + WS_XN), (const bf16*)(ws + WS_WGU0), E); } ENDPHASE(7)
    PHASE(8) { pg8::EpiF32 E{(float*)(ws + WS_SCR), D}; run_gemm<pg8::EpiF32, D, FF>(F, (const bf16*)(ws + WS_H), (const bf16*)(ws + WS_WD0), E); } ENDPHASE(8)
    PHASE(9) nr_pass(F, (const float*)(ws + WS_SCR), ap->out, ap->in[20], ap->out, (bf16*)(ws + WS_XN)); ENDPHASE(9)
    PHASE(10) { pg8::EpiBf16<0> E{(bf16*)(ws + WS_U), D, nullptr, 0, 0, 1.0f}; run_gemm<pg8::EpiBf16<0>, D, D>(F, (const bf16*)(ws + WS_XN), (const bf16*)(ws + WS_WSI), E); } ENDPHASE(10)
    PHASE(11) { Args a; for (int i = 0; i < 24; ++i) a.in[i] = ap->in[i]; a.out = ap->out; a.ws = ws; a.ph_lo = 0; a.ph_hi = 0; s5_naive(F, a); } ENDPHASE(11)
    PHASE(12) { pg8::EpiGlu E{(const bf16*)(ws + WS_Y), (bf16*)(ws + WS_Z), D}; run_gemm<pg8::EpiGlu, D, D>(F, (const bf16*)(ws + WS_Y), (const bf16*)(ws + WS_WSG), E); } ENDPHASE(12)
    PHASE(13) { pg8::EpiF32 E{(float*)(ws + WS_SCR), D}; run_gemm<pg8::EpiF32, D, D>(F, (const bf16*)(ws + WS_Z), (const bf16*)(ws + WS_WSO), E); } ENDPHASE(13)
    PHASE(14) nr_pass(F, (const float*)(ws + WS_SCR), ap->out, ap->in[18] + D, ap->out, (bf16*)(ws + WS_XN)); ENDPHASE(14)
    PHASE(15) { pg8::EpiSwiGLU E{(bf16*)(ws + WS_H), FF}; run_gemm<pg8::EpiSwiGLU, 2 * FF, D>(F, (const bf16*)(ws + WS_XN), (const bf16*)(ws + WS_WGU1), E); } ENDPHASE(15)
    PHASE(16) { pg8::EpiF32 E{(float*)(ws + WS_SCR), D}; run_gemm<pg8::EpiF32, D, FF>(F, (const bf16*)(ws + WS_H), (const bf16*)(ws + WS_WD1), E); } ENDPHASE(16)
    PHASE(17) nr_pass(F, (const float*)(ws + WS_SCR), ap->out, ap->in[20] + D, ap->out, nullptr); ENDPHASE(17)
#undef IN
#undef SEAM
#undef PHASE
#undef ENDPHASE
}

extern "C" void kernel_launch(void* const* d_in, const int* in_sizes, int n_in, void* d_out, int out_size, void* d_ws, size_t ws_size, hipStream_t stream) {
    static int grid = 0;
    if (grid == 0) {
        if (n_in != 24 || in_sizes[0] != M * D || out_size != M * D || ws_size < WS_END) { fprintf(stderr, "kernel_launch: shape/workspace mismatch (n_in %d, in0 %d, out %d, ws %zu)\n", n_in, n_in > 0 ? in_sizes[0] : -1, out_size, ws_size); grid = -1; return; }
        int dev = 0, cus = 0;
        if (hipGetDevice(&dev) != hipSuccess || hipDeviceGetAttribute(&cus, hipDeviceAttributeMultiprocessorCount, dev) != hipSuccess) { grid = -1; return; }
        if (hipFuncSetAttribute((const void*)mk_fwd, hipFuncAttributeMaxDynamicSharedMemorySize, LDS_BYTES) != hipSuccess) { fprintf(stderr, "kernel_launch: hipFuncSetAttribute failed\n"); grid = -1; return; }
        (void)hipGetLastError();
        grid = cus;
    }
    if (grid < 0) return;
    if (hipMemsetAsync((char*)d_ws + WS_CTL, 0, CTL_ZERO_BYTES, stream) != hipSuccess) return;
    Args a{};
    for (int i = 0; i < 24; ++i) a.in[i] = (const float*)d_in[i];
    a.out = (float*)d_out; a.ws = (unsigned char*)d_ws;
#if MK_ONE_LAUNCH
    a.ph_lo = 0; a.ph_hi = NPH;
    hipLaunchKernelGGL(mk_fwd, dim3(grid), dim3(NWAVES * 64), LDS_BYTES, stream, a);
#else
    for (int ph = 0; ph < NPH; ++ph) { a.ph_lo = ph; a.ph_hi = ph + 1; hipLaunchKernelGGL(mk_fwd, dim3(grid), dim3(NWAVES * 64), LDS_BYTES, stream, a); }
#endif
}
```

```cpp
#include <hip/hip_runtime.h>
#include <hip/hip_bf16.h>
#include <cstdio>
#include <cstdint>
namespace pg8 {
#define PG8_LAS __attribute__((address_space(3)))
typedef unsigned short bf16_t;
typedef short bf16x8 __attribute__((ext_vector_type(8)));
typedef float f32x4 __attribute__((ext_vector_type(4)));
typedef unsigned u32x4 __attribute__((ext_vector_type(4)));
constexpr int BM = 256, BK = 64, HALF = 128, HTB = HALF * BK * 2  , STAGE_BYTES = 8 * HTB, NXCD = 8, WGM = 8;

__host__ __device__ __forceinline__ int lds_byte(int r, int c) { const int st = (r >> 4) * 2 + (c >> 5), rr = r & 15, cc = c & 31, ob = rr * 64 + cc * 2; return st * 1024 + (ob ^ (((ob >> 9) & 1) << 5)); }
__host__ __device__ __forceinline__ void stage_rc(int b, int& R, int& C) { const int st = b / 1024, sb = b % 1024, swz = sb ^ (((sb >> 9) & 1) << 5); R = (st >> 1) * 16 + swz / 64; C = (st & 1) * 32 + (swz % 64) / 2; }
__host__ __device__ __forceinline__ int perm32(int rho) { const int n = rho >> 4, i = rho & 15; return 8 * (i >> 2) + 4 * n + (i & 3); }

struct Unit { int pm, pn; };
struct Gemm { const bf16_t* A; const bf16_t* Bt; int M, N, K; };

struct StaticOrder {
    int nM, nN, nwg, G, c;
    __host__ __device__ void init(int M, int N, int G_, int c_) { nM = M / BM; nN = N / BM; nwg = nM * nN; G = G_; c = c_; }
    __host__ __device__ bool next(int i, Unit& u) const {
        const long L = (long)i * G + c; if (L >= nwg) return false;
        int wgid = (int)L; { const int q = nwg / NXCD, r = nwg % NXCD, xcd = wgid % NXCD, off = wgid / NXCD; wgid = (xcd < r ? xcd * (q + 1) : r * (q + 1) + (xcd - r) * q) + off; }
        const int nig = WGM * nN, gid = wgid / nig, fm = gid * WGM, gsz = (nM - fm) < WGM ? (nM - fm) : WGM;
        u.pm = fm + ((wgid % nig) % gsz); u.pn = (wgid % nig) / gsz; return true;
    }
    __device__ __forceinline__ void a_ready(const Unit&) const {}
    __device__ __forceinline__ void done(const Unit&) const {}
};

__device__ __forceinline__ unsigned cvt_pk_bf16(float lo, float hi) { unsigned r; asm volatile("v_cvt_pk_bf16_f32 %0, %1, %2" : "=v"(r) : "v"(lo), "v"(hi)); return r; }
typedef float f32x2 __attribute__((ext_vector_type(2)));
__device__ __forceinline__ f32x2 gelu_pk(f32x2 v) {
    const f32x2 av = __builtin_elementwise_abs(v), d = av * 0.2316418882f + 1.0f;
    f32x2 t; t.x = __builtin_amdgcn_rcpf(d.x); t.y = __builtin_amdgcn_rcpf(d.y);
    f32x2 q = t * 0.5307027145f + (-0.7265760135f); q = q * t + 0.7107068705f; q = q * t + (-0.142248368f); q = q * t + 0.127414796f; q = q * t;
    const f32x2 s = (v * v) * (-0.72134752044f);
    f32x2 e; e.x = __builtin_amdgcn_exp2f(s.x); e.y = __builtin_amdgcn_exp2f(s.y);
    const f32x2 m = v * (q * e), r = v - m;
    f32x2 o; o.x = v.x < 0.f ? m.x : r.x; o.y = v.y < 0.f ? m.y : r.y; return o;
}

template <int ACT  > struct EpiBf16 {
    static constexpr bool PERM = true, AFTER_DRAIN = false; static_assert(ACT == 0 || ACT == 1, "EpiBf16: ACT is 0 (none) or 1 (gelu_pk)");
    bf16_t* O; int ldc; const float* bias; int split_cols; size_t split_stride; float scale0;
    __device__ __forceinline__ void operator()(const f32x4 (&acc)[2][2][4][2], const Unit& u, int wr, int wc, int fr, int fq) const {
        const int row0 = u.pm * BM + wr * 64 + fr; int colt = u.pn * BM; bf16_t* base = O;
        float sc = 1.f; if (split_cols) { const int t = colt / split_cols; base += (size_t)t * split_stride; colt -= t * split_cols; if (t == 0) sc = scale0; }
        const int col0 = colt + wc * 32 + 8 * fq, bcol0 = u.pn * BM + wc * 32 + 8 * fq;
        f32x4 bv[2][2];
#pragma unroll
        for (int bj = 0; bj < 2; ++bj)
#pragma unroll
            for (int n = 0; n < 2; ++n) bv[bj][n] = bias ? *(const f32x4*)(bias + bcol0 + bj * HALF + 4 * n) : (f32x4){0.f, 0.f, 0.f, 0.f};
#pragma unroll
        for (int ai = 0; ai < 2; ++ai)
#pragma unroll
            for (int m = 0; m < 4; ++m) { bf16_t* rowp = base + (size_t)(row0 + ai * HALF + m * 16) * ldc + col0;
#pragma unroll
                for (int bj = 0; bj < 2; ++bj) { f32x4 v0 = acc[ai][bj][m][0] + bv[bj][0], v1 = acc[ai][bj][m][1] + bv[bj][1];
                    if (ACT == 1) { f32x2 a = gelu_pk((f32x2){v0[0], v0[1]}), b = gelu_pk((f32x2){v0[2], v0[3]}), c = gelu_pk((f32x2){v1[0], v1[1]}), d = gelu_pk((f32x2){v1[2], v1[3]});
                        v0 = (f32x4){a.x, a.y, b.x, b.y}; v1 = (f32x4){c.x, c.y, d.x, d.y}; }
                    v0 = v0 * sc; v1 = v1 * sc; u32x4 w; w.x = cvt_pk_bf16(v0[0], v0[1]); w.y = cvt_pk_bf16(v0[2], v0[3]); w.z = cvt_pk_bf16(v1[0], v1[1]); w.w = cvt_pk_bf16(v1[2], v1[3]);
                    *(u32x4*)(rowp + bj * HALF) = w; } }
    }
};

struct PanelStats {
    unsigned* xbuf;
    unsigned* cnt;
    unsigned* tmo;
    int ntn; float eps;
    unsigned code;
    __device__ __forceinline__ bool run(const f32x4 (&v)[2][2][4][2], const Unit& u, int wr, int wc, int fr, int fq, PG8_LAS unsigned char* lds, int wid, int lane) const {
        typedef float f32x2v __attribute__((ext_vector_type(2)));
        PG8_LAS f32x2v* P = (PG8_LAS f32x2v*)lds;
        PG8_LAS f32x2v* S = (PG8_LAS f32x2v*)(lds + 8192);
        PG8_LAS unsigned* flag = (PG8_LAS unsigned*)(lds + 8192 + 2048);
#pragma unroll
        for (int ai = 0; ai < 2; ++ai)
#pragma unroll
            for (int m = 0; m < 4; ++m) {
                float s = 0.f;
#pragma unroll
                for (int bj = 0; bj < 2; ++bj)
#pragma unroll
                    for (int n = 0; n < 2; ++n) { const f32x4 x = v[ai][bj][m][n]; s += (x[0] + x[1]) + (x[2] + x[3]); }
                s += __shfl_xor(s, 16); s += __shfl_xor(s, 32);
                const float mw = s * (1.0f / 64.0f); float q = 0.f;
#pragma unroll
                for (int bj = 0; bj < 2; ++bj)
#pragma unroll
                    for (int n = 0; n < 2; ++n) { const f32x4 d = v[ai][bj][m][n] - mw; q += (d[0] * d[0] + d[1] * d[1]) + (d[2] * d[2] + d[3] * d[3]); }
                q += __shfl_xor(q, 16); q += __shfl_xor(q, 32);
                if (fq == 0) P[(ai * HALF + wr * 64 + m * 16 + fr) * 4 + wc] = (f32x2v){mw, q};
            }
        asm volatile("s_waitcnt lgkmcnt(0)" ::: "memory"); __builtin_amdgcn_s_barrier(); asm volatile("" ::: "memory");
#if defined(BROKEN_EXCHANGE_NO_WAIT)
#warning BROKEN CONTROL BUILD: the row-statistics exchange does not wait; results are wrong by design
        if (blockIdx.x >= 64) { const long long t0_ = clock64(); while (clock64() - t0_ < 60000) __builtin_amdgcn_s_sleep(8); }
#endif
        const int row = wid * 32 + (lane & 31);
        if (lane < 32) {
            const f32x2v a = P[row * 4 + 0], b = P[row * 4 + 1], c = P[row * 4 + 2], d = P[row * 4 + 3];
            const float mt = (a.x + b.x + c.x + d.x) * 0.25f;
            const float da = a.x - mt, db = b.x - mt, dc = c.x - mt, dd = d.x - mt;
            const float m2 = (a.y + b.y) + (c.y + d.y) + 64.0f * ((da * da + db * db) + (dc * dc + dd * dd));
            unsigned long long* slot = (unsigned long long*)xbuf + ((size_t)(u.pm * BM + row) * 4 + u.pn);
            __hip_atomic_store(slot, ((unsigned long long)__float_as_uint(m2) << 32) | __float_as_uint(mt), __ATOMIC_RELAXED, __HIP_MEMORY_SCOPE_AGENT);
        }
        asm volatile("s_waitcnt vmcnt(0)" ::: "memory");
        if (lane == 0) __hip_atomic_fetch_add(cnt + 64 * u.pm, 1u, __ATOMIC_RELAXED, __HIP_MEMORY_SCOPE_AGENT);
        if (wid == 0) {
            bool dead = false; const unsigned long long t0 = __builtin_amdgcn_s_memrealtime(); const unsigned want = 8u * (unsigned)ntn;
            for (;;) {
#if defined(BROKEN_EXCHANGE_NO_WAIT)
                break;
#endif
                if ((unsigned)__builtin_amdgcn_readfirstlane(__hip_atomic_load(cnt + 64 * u.pm, __ATOMIC_RELAXED, __HIP_MEMORY_SCOPE_AGENT)) >= want) break;
                if (__builtin_amdgcn_s_memrealtime() - t0 > 2000000ull) {
                    if (lane == 0) { unsigned expect = 0u; __hip_atomic_compare_exchange_strong(tmo + 1, &expect, code | (unsigned)(u.pm & 0xff), __ATOMIC_RELAXED, __ATOMIC_RELAXED, __HIP_MEMORY_SCOPE_AGENT);
                                     __hip_atomic_store(tmo, 1u, __ATOMIC_RELAXED, __HIP_MEMORY_SCOPE_AGENT); }
                    dead = true; break; }
                __builtin_amdgcn_s_sleep(2);
            }
            __builtin_amdgcn_fence(__ATOMIC_ACQUIRE, "agent");
            if (lane == 0) flag[0] = dead ? 1u : 0u;
        }
        asm volatile("s_waitcnt vmcnt(0) lgkmcnt(0)" ::: "memory"); __builtin_amdgcn_s_barrier(); asm volatile("" ::: "memory");
        const bool bad = flag[0] != 0u;
        if (lane < 32) {
            const unsigned long long* slot = (const unsigned long long*)xbuf + (size_t)(u.pm * BM + row) * 4; float mt[4], m2[4]; float ms = 0.f;
#pragma unroll
            for (int t = 0; t < 4; ++t) { if (t < ntn) { const unsigned long long w = __hip_atomic_load(slot + t, __ATOMIC_RELAXED, __HIP_MEMORY_SCOPE_AGENT); mt[t] = __uint_as_float((unsigned)w); m2[t] = __uint_as_float((unsigned)(w >> 32)); } else { mt[t] = 0.f; m2[t] = 0.f; } ms += mt[t]; }
            const float mean = ms / (float)ntn; float q = 0.f;
#pragma unroll
            for (int t = 0; t < 4; ++t) if (t < ntn) { const float dm = mt[t] - mean; q += m2[t] + 256.0f * dm * dm; }
            S[row] = (f32x2v){mean, 1.0f / sqrtf(q / (256.0f * (float)ntn) + eps)};
        }
        asm volatile("s_waitcnt lgkmcnt(0)" ::: "memory"); __builtin_amdgcn_s_barrier(); asm volatile("" ::: "memory");
        return bad;
    }
};
struct EpiLnRes {
    static constexpr bool PERM = false, AFTER_DRAIN = true;
    const float* base; float* out; int ldc; const float* bias; PanelStats st; unsigned poison;
    __device__ __forceinline__ void fused(f32x4 (&acc)[2][2][4][2], const Unit& u, int wr, int wc, int fr, int fq, PG8_LAS unsigned char* lds, int wid, int lane) const {
        typedef float f32x2v __attribute__((ext_vector_type(2)));
        const PG8_LAS f32x2v* S = (const PG8_LAS f32x2v*)(lds + 8192);
        const int col0 = u.pn * BM + wc * 32 + 4 * fq;
#pragma unroll
        for (int bj = 0; bj < 2; ++bj)
#pragma unroll
            for (int n = 0; n < 2; ++n) { const f32x4 bv = bias ? *(const f32x4*)(bias + col0 + bj * HALF + n * 16) : (f32x4){0.f, 0.f, 0.f, 0.f};
#pragma unroll
                for (int ai = 0; ai < 2; ++ai)
#pragma unroll
                    for (int m = 0; m < 4; ++m) acc[ai][bj][m][n] += bv; }
        f32x4 pre[4][2][2];
#pragma unroll
        for (int m = 0; m < 4; ++m) { const size_t off = (size_t)(u.pm * BM + wr * 64 + m * 16 + fr) * ldc + col0;
#pragma unroll
            for (int bj = 0; bj < 2; ++bj)
#pragma unroll
                for (int n = 0; n < 2; ++n) pre[m][bj][n] = *(const f32x4*)(base + off + bj * HALF + n * 16); }
        const bool bad = st.run(acc, u, wr, wc, fr, fq, lds, wid, lane) || poison != 0u;
        const float qnan = __builtin_nanf("");
#pragma unroll
        for (int ai = 0; ai < 2; ++ai)
#pragma unroll
            for (int m = 0; m < 4; ++m) { const int r = ai * HALF + wr * 64 + m * 16 + fr; const f32x2v sr = S[r]; const size_t off = (size_t)(u.pm * BM + r) * ldc + col0;
#pragma unroll
                for (int bj = 0; bj < 2; ++bj)
#pragma unroll
                    for (int n = 0; n < 2; ++n) { const f32x4 bs = ai == 0 ? pre[m][bj][n] : *(const f32x4*)(base + off + bj * HALF + n * 16); f32x4 o = bs + (acc[ai][bj][m][n] - sr.x) * sr.y;
                        if (bad) o = (f32x4){qnan, qnan, qnan, qnan}; *(f32x4*)(out + off + bj * HALF + n * 16) = o; }
                if (m & 1) asm volatile("" ::: "memory"); }
    }
};
struct EpiLnResLn {
    static constexpr bool PERM = false, AFTER_DRAIN = true;
    const float* base; float* out; bf16_t* xn; int ldc; const float* bias; PanelStats st1, st2; unsigned poison;
    __device__ __forceinline__ void fused(f32x4 (&acc)[2][2][4][2], const Unit& u, int wr, int wc, int fr, int fq, PG8_LAS unsigned char* lds, int wid, int lane) const {
        typedef float f32x2v __attribute__((ext_vector_type(2))); typedef unsigned u32x2v __attribute__((ext_vector_type(2)));
        const PG8_LAS f32x2v* S = (const PG8_LAS f32x2v*)(lds + 8192);
        const int col0 = u.pn * BM + wc * 32 + 4 * fq;
#pragma unroll
        for (int bj = 0; bj < 2; ++bj)
#pragma unroll
            for (int n = 0; n < 2; ++n) { const f32x4 bv = bias ? *(const f32x4*)(bias + col0 + bj * HALF + n * 16) : (f32x4){0.f, 0.f, 0.f, 0.f};
#pragma unroll
                for (int ai = 0; ai < 2; ++ai)
#pragma unroll
                    for (int m = 0; m < 4; ++m) acc[ai][bj][m][n] += bv; }
        bool bad = st1.run(acc, u, wr, wc, fr, fq, lds, wid, lane) || poison != 0u;
        const float qnan = __builtin_nanf("");
#pragma unroll
        for (int ai = 0; ai < 2; ++ai)
#pragma unroll
            for (int m = 0; m < 4; ++m) { const int r = ai * HALF + wr * 64 + m * 16 + fr; const f32x2v sr = S[r]; const size_t off = (size_t)(u.pm * BM + r) * ldc + col0;
#pragma unroll
                for (int bj = 0; bj < 2; ++bj)
#pragma unroll
                    for (int n = 0; n < 2; ++n) { const f32x4 bs = *(const f32x4*)(base + off + bj * HALF + n * 16); acc[ai][bj][m][n] = bs + (acc[ai][bj][m][n] - sr.x) * sr.y; }
                asm volatile("" : "+v"(acc[ai][0][m][0]), "+v"(acc[ai][0][m][1]), "+v"(acc[ai][1][m][0]), "+v"(acc[ai][1][m][1]));
                if (m & 1) asm volatile("" ::: "memory"); }
        const bool bad1 = bad;
        bad = st2.run(acc, u, wr, wc, fr, fq, lds, wid, lane) || bad;
#pragma unroll
        for (int ai = 0; ai < 2; ++ai)
#pragma unroll
            for (int m = 0; m < 4; ++m) { const int r = ai * HALF + wr * 64 + m * 16 + fr; const f32x2v sr = S[r]; const size_t off = (size_t)(u.pm * BM + r) * ldc + col0;
#pragma unroll
                for (int bj = 0; bj < 2; ++bj)
#pragma unroll
                    for (int n = 0; n < 2; ++n) { const f32x4 x1 = acc[ai][bj][m][n]; *(f32x4*)(out + off + bj * HALF + n * 16) = bad1 ? (f32x4){qnan, qnan, qnan, qnan} : x1;
                        const f32x4 o = (x1 - sr.x) * sr.y; u32x2v w; w.x = cvt_pk_bf16(o[0], o[1]); w.y = cvt_pk_bf16(o[2], o[3]);
                        if (bad) { w.x = 0x7fc07fc0u; w.y = 0x7fc07fc0u; } *(u32x2v*)(xn + off + bj * HALF + n * 16) = w; }
                asm volatile("" ::: "memory"); }
    }
};

template <class Epi, class Sched, bool ALIGN_EPI = false, bool SP2 = false>
__device__ __forceinline__ void gemm_phase(PG8_LAS unsigned char* lds, const Gemm g, const Sched& S, const Epi& E) {
    const int tid = threadIdx.x, wid = __builtin_amdgcn_readfirstlane(tid >> 6), lane = tid & 63, wr = wid >> 2, wc = wid & 3, fr = lane & 15, fq = lane >> 4;
    const int K = g.K, nt = K / BK;
    unsigned voffA[2], voffB[2];
#pragma unroll
    for (int i = 0; i < 2; ++i) { int R, C; stage_rc(tid * 16 + i * 8192, R, C); const int Rb = Epi::PERM ? ((R & ~31) + perm32(R & 31)) : R;
        voffA[i] = (unsigned)(R * K + C) * 2u; voffB[i] = (unsigned)(Rb * K + C) * 2u; }
    const size_t kstep = (size_t)(BK * 2);
    const size_t hstep = (size_t)HALF * K * 2;
    const size_t tstep = 2 * hstep;
    const unsigned ldsw = (unsigned)wid * 1024u;
    const int aoff = lds_byte(wr * 64 + fr, fq * 8), boff = lds_byte(wc * 32 + fr, fq * 8);
#define PG8_SA(b, h) (((b) * 2 + (h)) * HTB)
#define PG8_SB(b, h) ((4 + (b) * 2 + (h)) * HTB)
#define PG8_STAGE(bufoff, gbase, voff) do { _Pragma("unroll") for (int _i = 0; _i < 2; ++_i) \
        __builtin_amdgcn_global_load_lds((const unsigned*)((const char*)(gbase) + (voff)[_i]), (PG8_LAS unsigned*)(lds + (bufoff) + ldsw + _i * 8192), 16, 0, 0); } while (0)
#define PG8_LDA(dst, b, h) do { _Pragma("unroll") for (int m = 0; m < 4; ++m) _Pragma("unroll") for (int k = 0; k < 2; ++k) dst[m][k] = *(const PG8_LAS bf16x8*)(lds + PG8_SA(b, h) + aoff + m * 2048 + k * 1024); } while (0)
#define PG8_LDB(dst, b, h) do { _Pragma("unroll") for (int n = 0; n < 2; ++n) _Pragma("unroll") for (int k = 0; k < 2; ++k) dst[n][k] = *(const PG8_LAS bf16x8*)(lds + PG8_SB(b, h) + boff + n * 2048 + k * 1024); } while (0)
#define PG8_MMA(ai, bj, At, Bt) do { __builtin_amdgcn_s_setprio(1); _Pragma("unroll") for (int m = 0; m < 4; ++m) _Pragma("unroll") for (int n = 0; n < 2; ++n) _Pragma("unroll") for (int k = 0; k < 2; ++k) \
        acc[ai][bj][m][n] = __builtin_amdgcn_mfma_f32_16x16x32_bf16(Bt[n][k], At[m][k], acc[ai][bj][m][n], 0, 0, 0); __builtin_amdgcn_s_setprio(0); } while (0)
#define PG8_WAIT_V(n) asm volatile("s_waitcnt vmcnt(" #n ")" ::: "memory")
#define PG8_WAIT_L(n) asm volatile("s_waitcnt lgkmcnt(" #n ")" ::: "memory")
#define PG8_BAR __builtin_amdgcn_s_barrier()
#define PG8_SCHED __builtin_amdgcn_sched_barrier(0)
    Unit cur, nxt; int ui = 0;
    if (!S.next(0, cur)) return;
    f32x4 acc[2][2][4][2];
#pragma unroll
    for (int a = 0; a < 2; ++a)
#pragma unroll
        for (int b = 0; b < 2; ++b)
#pragma unroll
            for (int m = 0; m < 4; ++m)
#pragma unroll
                for (int n = 0; n < 2; ++n) acc[a][b][m][n] = (f32x4){0.f, 0.f, 0.f, 0.f};
    bf16x8 At[4][2], B0[2][2], B1[2][2];
    const char* cA = (const char*)g.A + (size_t)cur.pm * tstep; const char* cB = (const char*)g.Bt + (size_t)cur.pn * tstep;
    S.a_ready(cur);
    if constexpr (SP2) {
        PG8_STAGE(PG8_SB(0, 0), cB, voffB); PG8_STAGE(PG8_SB(0, 1), cB + hstep, voffB); PG8_STAGE(PG8_SA(0, 0), cA, voffA); PG8_STAGE(PG8_SA(0, 1), cA + hstep, voffA);
        if (wr == 1) PG8_BAR;
        PG8_WAIT_V(2); PG8_BAR;
        PG8_STAGE(PG8_SB(1, 0), cB + kstep, voffB); PG8_STAGE(PG8_SA(1, 0), cA + kstep, voffA); PG8_STAGE(PG8_SB(1, 1), cB + hstep + kstep, voffB);
        PG8_WAIT_V(6); PG8_BAR;
    } else {
        PG8_STAGE(PG8_SB(0, 0), cB, voffB); PG8_STAGE(PG8_SA(0, 0), cA, voffA); PG8_STAGE(PG8_SB(0, 1), cB + hstep, voffB); PG8_STAGE(PG8_SA(0, 1), cA + hstep, voffA);
        if (wr == 1) PG8_BAR;
        PG8_WAIT_V(4); PG8_BAR;
        PG8_STAGE(PG8_SB(1, 0), cB + kstep, voffB); PG8_STAGE(PG8_SA(1, 0), cA + kstep, voffA); PG8_STAGE(PG8_SB(1, 1), cB + hstep + kstep, voffB);
        PG8_WAIT_V(6); PG8_BAR;
    }
    for (;;) {
        const bool has_next = S.next(ui + 1, nxt);
        const char* nA = has_next ? (const char*)g.A + (size_t)nxt.pm * tstep : cA; const char* nB = has_next ? (const char*)g.Bt + (size_t)nxt.pn * tstep : cB;
        for (int t = 0; t < nt; t += 2) {
            const bool last = (t == nt - 2);
            const char* a1 = cA + (size_t)(t + 1) * kstep;
            const char* a2 = last ? nA : cA + (size_t)(t + 2) * kstep; const char* b2 = last ? nB : cB + (size_t)(t + 2) * kstep;
            const char* a3 = a2 + kstep; const char* b3 = b2 + kstep;
            if (last && has_next) S.a_ready(nxt);
            if constexpr (SP2) {
            PG8_LDB(B0, 0, 0); PG8_LDB(B1, 0, 1); PG8_SCHED; PG8_LDA(At, 0, 0); PG8_STAGE(PG8_SA(1, 1), a1 + hstep, voffA);
            PG8_WAIT_V(8); PG8_WAIT_L(0); PG8_BAR; PG8_MMA(0, 0, At, B0); PG8_MMA(0, 1, At, B1); PG8_BAR; PG8_SCHED;
            PG8_LDA(At, 0, 1); PG8_STAGE(PG8_SB(0, 0), b2, voffB); PG8_STAGE(PG8_SB(0, 1), b2 + hstep, voffB); PG8_STAGE(PG8_SA(0, 0), a2, voffA);
            PG8_WAIT_V(8); PG8_WAIT_L(0); PG8_BAR; PG8_MMA(1, 0, At, B0); PG8_MMA(1, 1, At, B1); PG8_BAR; PG8_SCHED;
            PG8_LDB(B0, 1, 0); PG8_LDB(B1, 1, 1); PG8_SCHED; PG8_LDA(At, 1, 0); PG8_STAGE(PG8_SA(0, 1), a2 + hstep, voffA);
            PG8_WAIT_V(8); PG8_WAIT_L(0); PG8_BAR; PG8_MMA(0, 0, At, B0); PG8_MMA(0, 1, At, B1); PG8_BAR; PG8_SCHED;
            PG8_LDA(At, 1, 1); PG8_STAGE(PG8_SB(1, 0), b3, voffB); PG8_STAGE(PG8_SB(1, 1), b3 + hstep, voffB); PG8_STAGE(PG8_SA(1, 0), a3, voffA);
            PG8_WAIT_V(8); PG8_WAIT_L(0); PG8_BAR; PG8_MMA(1, 0, At, B0); PG8_MMA(1, 1, At, B1); PG8_BAR; PG8_SCHED;
            } else {
            PG8_LDB(B0, 0, 0); PG8_SCHED; PG8_LDA(At, 0, 0); PG8_STAGE(PG8_SA(1, 1), a1 + hstep, voffA);
            PG8_WAIT_L(8); PG8_BAR; PG8_WAIT_L(0); PG8_MMA(0, 0, At, B0); PG8_BAR; PG8_SCHED;
            PG8_LDB(B1, 0, 1); PG8_STAGE(PG8_SB(0, 0), b2, voffB);
            PG8_BAR; PG8_WAIT_L(0); PG8_MMA(0, 1, At, B1); PG8_BAR;
            PG8_LDA(At, 0, 1); PG8_STAGE(PG8_SA(0, 0), a2, voffA);
            PG8_BAR; PG8_WAIT_L(0); PG8_MMA(1, 0, At, B0); PG8_BAR; PG8_SCHED;
            PG8_STAGE(PG8_SB(0, 1), b2 + hstep, voffB);
            PG8_WAIT_V(6); PG8_BAR; PG8_MMA(1, 1, At, B1); PG8_BAR;
            PG8_LDB(B0, 1, 0); PG8_SCHED; PG8_LDA(At, 1, 0); PG8_STAGE(PG8_SA(0, 1), a2 + hstep, voffA);
            PG8_WAIT_L(8); PG8_BAR; PG8_WAIT_L(0); PG8_MMA(0, 0, At, B0); PG8_BAR; PG8_SCHED;
            PG8_LDB(B1, 1, 1); PG8_STAGE(PG8_SB(1, 0), b3, voffB);
            PG8_BAR; PG8_WAIT_L(0); PG8_MMA(0, 1, At, B1); PG8_BAR;
            PG8_LDA(At, 1, 1); PG8_STAGE(PG8_SA(1, 0), a3, voffA);
            PG8_BAR; PG8_WAIT_L(0); PG8_MMA(1, 0, At, B0); PG8_BAR; PG8_SCHED;
            PG8_STAGE(PG8_SB(1, 1), b3 + hstep, voffB);
            PG8_WAIT_V(6); PG8_BAR; PG8_MMA(1, 1, At, B1); PG8_BAR;
            }
        }
        if constexpr (ALIGN_EPI) { if (wr == 0) PG8_BAR; }
        if constexpr (!Epi::AFTER_DRAIN) { E(acc, cur, wr, wc, fr, fq); S.done(cur); }
        if (!has_next) break;
#pragma unroll
        for (int a = 0; a < 2; ++a)
#pragma unroll
            for (int b = 0; b < 2; ++b)
#pragma unroll
                for (int m = 0; m < 4; ++m)
#pragma unroll
                    for (int n = 0; n < 2; ++n) acc[a][b][m][n] = (f32x4){0.f, 0.f, 0.f, 0.f};
        cur = nxt; cA = nA; cB = nB; ++ui;
        if constexpr (ALIGN_EPI) { if (wr == 1) PG8_BAR; }
    }
    PG8_WAIT_V(0);
    if constexpr (!ALIGN_EPI) { if (wr == 0) PG8_BAR; }
    PG8_BAR;
    if constexpr (Epi::AFTER_DRAIN) { E.fused(acc, cur, wr, wc, fr, fq, lds, wid, lane); S.done(cur); }
#undef PG8_SA
#undef PG8_SB
#undef PG8_STAGE
#undef PG8_LDA
#undef PG8_LDB
#undef PG8_MMA
#undef PG8_WAIT_V
#undef PG8_WAIT_L
#undef PG8_BAR
#undef PG8_SCHED
}
}
namespace pg8 {
struct EpiF32 {
    static constexpr bool PERM = false, AFTER_DRAIN = false;
    float* C; int ldc;
    __device__ __forceinline__ void operator()(const f32x4 (&acc)[2][2][4][2], const Unit& u, int wr, int wc, int fr, int fq) const {
        const int row0 = u.pm * BM + wr * 64 + fr, col0 = u.pn * BM + wc * 32 + 4 * fq;
#pragma unroll
        for (int ai = 0; ai < 2; ++ai)
#pragma unroll
            for (int m = 0; m < 4; ++m) { float* rowp = C + (size_t)(row0 + ai * HALF + m * 16) * ldc + col0;
#pragma unroll
                for (int bj = 0; bj < 2; ++bj)
#pragma unroll
                    for (int n = 0; n < 2; ++n) *(f32x4*)(rowp + bj * HALF + n * 16) = acc[ai][bj][m][n]; }
    }
};
__device__ __forceinline__ float sigmoid_f(float v) { return __builtin_amdgcn_rcpf(1.0f + __builtin_amdgcn_exp2f(-1.4426950408889634f * v)); }
struct EpiSwiGLU {
    static constexpr bool PERM = true, AFTER_DRAIN = false;
    bf16_t* Hh; int ldh;
    __device__ __forceinline__ void operator()(const f32x4 (&acc)[2][2][4][2], const Unit& u, int wr, int wc, int fr, int fq) const {
        const int row0 = u.pm * BM + wr * 64 + fr, col0 = u.pn * HALF + wc * 32 + 8 * fq;
#pragma unroll
        for (int ai = 0; ai < 2; ++ai)
#pragma unroll
            for (int m = 0; m < 4; ++m) { bf16_t* rowp = Hh + (size_t)(row0 + ai * HALF + m * 16) * ldh + col0;
                float h[8];
#pragma unroll
                for (int n = 0; n < 2; ++n)
#pragma unroll
                    for (int e = 0; e < 4; ++e) { const float g = acc[ai][0][m][n][e], up = acc[ai][1][m][n][e]; h[4 * n + e] = g * sigmoid_f(g) * up; }
                u32x4 w; w.x = cvt_pk_bf16(h[0], h[1]); w.y = cvt_pk_bf16(h[2], h[3]); w.z = cvt_pk_bf16(h[4], h[5]); w.w = cvt_pk_bf16(h[6], h[7]);
                *(u32x4*)rowp = w; }
    }
};
__device__ __forceinline__ float bf_lo(unsigned w) { return __builtin_bit_cast(float, w << 16); }
__device__ __forceinline__ float bf_hi(unsigned w) { return __builtin_bit_cast(float, w & 0xffff0000u); }
struct EpiGlu {
    static constexpr bool PERM = true, AFTER_DRAIN = false;
    const bf16_t* Y; bf16_t* Z; int ldc;
    __device__ __forceinline__ void operator()(const f32x4 (&acc)[2][2][4][2], const Unit& u, int wr, int wc, int fr, int fq) const {
        const int row0 = u.pm * BM + wr * 64 + fr, col0 = u.pn * BM + wc * 32 + 8 * fq;
#pragma unroll
        for (int ai = 0; ai < 2; ++ai)
#pragma unroll
            for (int m = 0; m < 4; ++m) { const size_t off = (size_t)(row0 + ai * HALF + m * 16) * ldc + col0;
#pragma unroll
                for (int bj = 0; bj < 2; ++bj) { const u32x4 y = *(const u32x4*)(Y + off + bj * HALF); const f32x4 a0 = acc[ai][bj][m][0], a1 = acc[ai][bj][m][1];
                    u32x4 w;
                    w.x = cvt_pk_bf16(bf_lo(y.x) * sigmoid_f(a0[0]), bf_hi(y.x) * sigmoid_f(a0[1]));
                    w.y = cvt_pk_bf16(bf_lo(y.y) * sigmoid_f(a0[2]), bf_hi(y.y) * sigmoid_f(a0[3]));
                    w.z = cvt_pk_bf16(bf_lo(y.z) * sigmoid_f(a1[0]), bf_hi(y.z) * sigmoid_f(a1[1]));
                    w.w = cvt_pk_bf16(bf_lo(y.w) * sigmoid_f(a1[2]), bf_hi(y.w) * sigmoid_f(a1[3]));
                    *(u32x4*)(Z + off + bj * HALF) = w; } }
    }
};
}
#ifndef PG8_SP2
#define PG8_SP2 true
#endif
#ifndef PG8_ALIGN
#define PG8_ALIGN true
#endif
#ifndef MK_ONE_LAUNCH
#define MK_ONE_LAUNCH 1
#endif
constexpr int NWAVES = 8;
constexpr int BATCH = 16, SEQ = 2048, D = 1024, NH = 16, HD = 64, FF = 2816, M = BATCH * SEQ;
constexpr int NFOX = 4 * D + NH;
constexpr int NG = 64, NP = 64, GC = 16;
constexpr float EPS = 1e-6f;
constexpr float LOG2E = 1.4426950408889634f;
constexpr float C2 = 0.125f * LOG2E;
constexpr size_t MiB = 1u << 20;
constexpr size_t WS_CTL = 0, CTL_ZERO_BYTES = 1 * MiB;
constexpr size_t WS_WFOX = 2 * MiB;
constexpr size_t WS_WF = 10 * MiB;
constexpr size_t WS_WFO = 11 * MiB, WS_WSI = 13 * MiB, WS_WSG = 15 * MiB, WS_WSO = 17 * MiB;
constexpr size_t WS_WGU0 = 19 * MiB, WS_WD0 = 30 * MiB, WS_WGU1 = 36 * MiB, WS_WD1 = 47 * MiB;
constexpr size_t WS_LOGF = 54 * MiB;
constexpr size_t WS_XCH = 56 * MiB;
constexpr size_t WS_XN = 64 * MiB;
constexpr size_t WS_Q = 128 * MiB, WS_K = 192 * MiB, WS_V = 256 * MiB, WS_GT = 320 * MiB;
constexpr size_t WS_H = 128 * MiB;
constexpr size_t WS_U = 128 * MiB, WS_Y = 192 * MiB, WS_Z = 256 * MiB;
constexpr size_t WS_SCR = 320 * MiB;
constexpr size_t WS_END = 448 * MiB;
constexpr int CW_TMO = 0, CW_CODE = 1, CW_BAR = 4096;
constexpr int RING_OFF = 0, RING_BYTES = 131072;
constexpr int LDSCTL_OFF = RING_BYTES, MISC_OFF = LDSCTL_OFF + 320;
constexpr int LDS_BYTES = 147456;
#define GAS __attribute__((address_space(1)))
#define LAS __attribute__((address_space(3)))
typedef unsigned short bf16;
typedef unsigned v4u __attribute__((ext_vector_type(4)));
typedef float f32x4 __attribute__((ext_vector_type(4)));
typedef GAS unsigned gu32;
#define RLX_AGENT __ATOMIC_RELAXED, __HIP_MEMORY_SCOPE_AGENT
#define LDS_WAIT() asm volatile("s_waitcnt lgkmcnt(0)" ::: "memory")
#define VM_WAIT() asm volatile("s_waitcnt vmcnt(0)" ::: "memory")
__device__ __forceinline__ unsigned f2bf(float f) { unsigned u = __builtin_bit_cast(unsigned, f); return (u + 0x7fffu + ((u >> 16) & 1u)) >> 16; }
__device__ __forceinline__ unsigned pk2(float lo, float hi) { return f2bf(lo) | (f2bf(hi) << 16); }
__device__ __forceinline__ float bflo(unsigned w) { return __builtin_bit_cast(float, w << 16); }
__device__ __forceinline__ float bfhi(unsigned w) { return __builtin_bit_cast(float, w & 0xffff0000u); }
__device__ __forceinline__ float sigm(float v) { return __builtin_amdgcn_rcpf(1.0f + __builtin_amdgcn_exp2f(-LOG2E * v)); }

#define XB_TMO      128
#define XB_XCNT(j)  (256  + 64 * (j))
#define XB_XSUB(j)  (1280 + 64 * (j))
#define XB_XGEN(j)  (2304 + 64 * (j))
#define XB_TOP      3328
#define XB_TOPGEN   3392
#define XCD_BAR_WORDS 3456
#define XB_SPIN_CAP (1u << 18)
__device__ __forceinline__ unsigned xb_ld(unsigned* p)              { return __hip_atomic_load(p, __ATOMIC_RELAXED, __HIP_MEMORY_SCOPE_AGENT); }
__device__ __forceinline__ unsigned xb_add(unsigned* p, unsigned v) { return __hip_atomic_fetch_add(p, v, __ATOMIC_RELAXED, __HIP_MEMORY_SCOPE_AGENT); }
__device__ __forceinline__ unsigned xb_xcc_id() { return (unsigned)__builtin_amdgcn_s_getreg((3 << 11) | 20) & 0xFu; }
#define XB_SPIN(cond, bar) do { unsigned _sp = 0; while (cond) { __builtin_amdgcn_s_sleep(1); \
    if ((++_sp & 255u) == 0u) { if (xb_ld(&(bar)[XB_TMO])) break; if (_sp > XB_SPIN_CAP) { atomicAdd(&(bar)[XB_TMO], 1u); break; } } } } while (0)
struct XcdBarrier { unsigned* bar; unsigned x; volatile LAS unsigned* st; };
__device__ __forceinline__ XcdBarrier xcd_barrier_post(unsigned* bar, volatile LAS unsigned* st) {
    XcdBarrier b; b.bar = bar; b.x = xb_xcc_id(); b.st = st;
    if (threadIdx.x == 0) (void)xb_add(&bar[XB_XCNT(b.x)], 1u);
    return b;
}
__device__ __forceinline__ void xcd_barrier_complete(unsigned* bar, unsigned x, unsigned& nloc, unsigned& nx) {
    const unsigned G = gridDim.x * gridDim.y * gridDim.z;
    unsigned sum, cnt, mine, sp = 0u;
    for (;;) {
        sum = 0u; cnt = 0u; mine = 0u;
#pragma unroll
        for (unsigned j = 0; j < 16; ++j) { const unsigned c = xb_ld(&bar[XB_XCNT(j)]); sum += c; cnt += (c > 0u) ? 1u : 0u; mine = (j == x) ? c : mine; }
        if (sum == G) break;
        __builtin_amdgcn_s_sleep(1);
        if ((++sp & 255u) == 0u) { if (xb_ld(&bar[XB_TMO])) break; if (sp > XB_SPIN_CAP) { atomicAdd(&bar[XB_TMO], 1u); break; } }
    }
    nloc = mine > 0u ? mine : 1u; nx = cnt > 0u ? cnt : 1u;
}
__device__ __forceinline__ void xcd_barrier(const XcdBarrier& b) {
    asm volatile("s_waitcnt vmcnt(0)" ::: "memory");
    __syncthreads();
    if (threadIdx.x == 0) {
        unsigned* bar = b.bar;
        __builtin_amdgcn_s_waitcnt(0);
        unsigned nloc = b.st[0], nx = b.st[1];
        if (nloc == 0u) { xcd_barrier_complete(bar, b.x, nloc, nx); b.st[0] = nloc; b.st[1] = nx; }
        const unsigned old = xb_add(&bar[XB_XSUB(b.x)], 1u);
        const unsigned gen = old / nloc;
        if (old + 1u == (gen + 1u) * nloc) {
            __builtin_amdgcn_fence(__ATOMIC_RELEASE, "agent");
            asm volatile("s_waitcnt vmcnt(0)" ::: "memory");
            const unsigned og = xb_add(&bar[XB_TOP], 1u);
            const unsigned tg = og / nx;
            if (og + 1u == (tg + 1u) * nx) xb_add(&bar[XB_TOPGEN], 1u);
            else XB_SPIN(xb_ld(&bar[XB_TOPGEN]) == tg, bar);
            __builtin_amdgcn_fence(__ATOMIC_ACQUIRE, "agent");
            xb_add(&bar[XB_XGEN(b.x)], 1u);
            asm volatile("s_waitcnt vmcnt(0)" ::: "memory");
        } else {
            XB_SPIN(xb_ld(&bar[XB_XGEN(b.x)]) == gen, bar);
            __builtin_amdgcn_fence(__ATOMIC_ACQUIRE, "agent");
            asm volatile("s_waitcnt vmcnt(0)" ::: "memory");
        }
    }
    __syncthreads();
}

struct Args { const float* in[24]; float* out; unsigned char* ws; int ph_lo, ph_hi; };
struct Frame {
    LAS unsigned char* lds;
    volatile LAS unsigned* MISC;
    gu32* ctl;
    int tid, lane, wave, vcu, G;
    unsigned char* ws;
    float* out;
};
__device__ __forceinline__ float wave_sum(float v) {
#pragma unroll
    for (int o = 1; o < 64; o <<= 1) v += __shfl_xor(v, o);
    return v;
}
__device__ __forceinline__ void transpose_item(const float* W, int ldw, const float* gain, bf16* WT, int K, int k0, int n0, int drow0, LAS float* scr, int lane) {
#pragma unroll 8
    for (int i = 0; i < 32; ++i) { const int kk = 2 * i + (lane >> 5); const float g = gain ? gain[k0 + kk] : 1.f; scr[kk * 33 + (lane & 31)] = W[(size_t)(k0 + kk) * ldw + n0 + (lane & 31)] * g; }
    LDS_WAIT(); asm volatile("" ::: "memory");
    const int c = lane & 7;
#pragma unroll
    for (int j = 0; j < 4; ++j) { const int n = (lane >> 3) + 8 * j; const LAS float* s = scr + (8 * c) * 33 + n;
        v4u o; o.x = pk2(s[0 * 33], s[1 * 33]); o.y = pk2(s[2 * 33], s[3 * 33]); o.z = pk2(s[4 * 33], s[5 * 33]); o.w = pk2(s[6 * 33], s[7 * 33]);
        *(GAS v4u*)(WT + (size_t)(drow0 + n) * K + k0 + 8 * c) = o; }
    LDS_WAIT(); asm volatile("" ::: "memory");
}
__device__ __forceinline__ void rms_row_to_bf16(const float* xrow, bf16* orow, int lane) {
    const GAS f32x4* xr = (const GAS f32x4*)xrow + lane;
    f32x4 v[4]; float s = 0.f;
#pragma unroll
    for (int j = 0; j < 4; ++j) { v[j] = xr[64 * j]; s += (v[j].x * v[j].x + v[j].y * v[j].y) + (v[j].z * v[j].z + v[j].w * v[j].w); }
    const float r = 1.0f / sqrtf(wave_sum(s) * (1.f / D) + EPS);
    GAS unsigned long long* o8 = (GAS unsigned long long*)orow + lane;
#pragma unroll
    for (int j = 0; j < 4; ++j) o8[64 * j] = (unsigned long long)pk2(v[j].x * r, v[j].y * r) | ((unsigned long long)pk2(v[j].z * r, v[j].w * r) << 32);
}
__device__ __forceinline__ void p0_prologue(Frame& F, const Args& A) {
    LAS float* scr = (LAS float*)(F.lds + RING_OFF + F.wave * 16384);
    const int gw = F.vcu * NWAVES + F.wave, NGW = F.G * NWAVES;
    constexpr int I_FOX = 16 * 128, I_SQ = 16 * 32, I_FF = 16 * 88, I_DN = 44 * 32;
    constexpr int NITEMS = I_FOX + 4 * I_SQ + 4 * I_FF + 2 * I_DN;
    unsigned char* ws = F.ws;
    for (int it = gw; it < NITEMS; it += NGW) {
        int r = it; const float* W; int ldw; const float* gain; bf16* WT; int K, N, mode;
        if (r < I_FOX) { W = A.in[1]; ldw = NFOX; gain = A.in[17]; WT = (bf16*)(ws + WS_WFOX); K = D; N = 4 * D; mode = 0; }
        else if ((r -= I_FOX) < I_SQ) { W = A.in[5]; ldw = D; gain = nullptr; WT = (bf16*)(ws + WS_WFO); K = D; N = D; mode = 0; }
        else if ((r -= I_SQ) < I_SQ) { W = A.in[6]; ldw = D; gain = A.in[17] + D; WT = (bf16*)(ws + WS_WSI); K = D; N = D; mode = 0; }
        else if ((r -= I_SQ) < I_SQ) { W = A.in[15]; ldw = D; gain = nullptr; WT = (bf16*)(ws + WS_WSG); K = D; N = D; mode = 0; }
        else if ((r -= I_SQ) < I_SQ) { W = A.in[16]; ldw = D; gain = nullptr; WT = (bf16*)(ws + WS_WSO); K = D; N = D; mode = 0; }
        else if ((r -= I_SQ) < I_FF) { W = A.in[21]; ldw = FF; gain = A.in[19]; WT = (bf16*)(ws + WS_WGU0); K = D; N = FF; mode = 1; }
        else if ((r -= I_FF) < I_FF) { W = A.in[22]; ldw = FF; gain = A.in[19]; WT = (bf16*)(ws + WS_WGU0); K = D; N = FF; mode = 2; }
        else if ((r -= I_FF) < I_DN) { W = A.in[23]; ldw = D; gain = nullptr; WT = (bf16*)(ws + WS_WD0); K = FF; N = D; mode = 0; }
        else if ((r -= I_DN) < I_FF) { W = A.in[21] + (size_t)D * FF; ldw = FF; gain = A.in[19] + D; WT = (bf16*)(ws + WS_WGU1); K = D; N = FF; mode = 1; }
        else if ((r -= I_FF) < I_FF) { W = A.in[22] + (size_t)D * FF; ldw = FF; gain = A.in[19] + D; WT = (bf16*)(ws + WS_WGU1); K = D; N = FF; mode = 2; }
        else { r -= I_FF; W = A.in[23] + (size_t)FF * D; ldw = D; gain = nullptr; WT = (bf16*)(ws + WS_WD1); K = FF; N = D; mode = 0; }
        const int nnb = N / 32, kb = r / nnb, nb = r % nnb, k0 = 64 * kb, n0 = 32 * nb;
        const int drow0 = (mode == 0) ? n0 : (256 * (n0 / 128) + (n0 % 128) + (mode == 2 ? 128 : 0));
        transpose_item(W, ldw, gain, WT, K, k0, n0, drow0, scr, F.lane);
    }
    {
        const int gt = gw * 64 + F.lane, NT = NGW * 64; bf16* WF = (bf16*)(ws + WS_WF);
        for (int e = gt; e < NH * D; e += NT) { const int h = e & 15, k = e >> 4; WF[h * D + k] = (bf16)f2bf(A.in[1][(size_t)k * NFOX + 4 * D + h] * A.in[17][k]); }
    }
    bf16* XN = (bf16*)(ws + WS_XN);
    for (int m = gw; m < M; m += NGW) rms_row_to_bf16(A.in[0] + (size_t)m * D, XN + (size_t)m * D, F.lane);
}
__device__ __forceinline__ void nr_pass(Frame& F, const float* acc, const float* xin, const float* gain, float* xout, bf16* xn) {
    const int gw = F.vcu * NWAVES + F.wave, NGW = F.G * NWAVES;
    for (int m = gw; m < M; m += NGW) {
        const GAS f32x4* ar = (const GAS f32x4*)(acc + (size_t)m * D) + F.lane; const GAS f32x4* xr = (const GAS f32x4*)(xin + (size_t)m * D) + F.lane;
        const GAS f32x4* gr = (const GAS f32x4*)gain + F.lane; GAS f32x4* orow = (GAS f32x4*)(xout + (size_t)m * D) + F.lane;
        f32x4 a[4], x[4]; float s = 0.f;
#pragma unroll
        for (int j = 0; j < 4; ++j) { a[j] = ar[64 * j]; x[j] = xr[64 * j]; s += (a[j].x * a[j].x + a[j].y * a[j].y) + (a[j].z * a[j].z + a[j].w * a[j].w); }
        const float r = 1.0f / sqrtf(wave_sum(s) * (1.f / D) + EPS); float s2 = 0.f;
#pragma unroll
        for (int j = 0; j < 4; ++j) { x[j] = x[j] + a[j] * r * gr[64 * j]; orow[64 * j] = x[j]; s2 += (x[j].x * x[j].x + x[j].y * x[j].y) + (x[j].z * x[j].z + x[j].w * x[j].w); }
        if (xn) { const float r2 = 1.0f / sqrtf(wave_sum(s2) * (1.f / D) + EPS);
            GAS unsigned long long* o8 = (GAS unsigned long long*)(xn + (size_t)m * D) + F.lane;
#pragma unroll
            for (int j = 0; j < 4; ++j) o8[64 * j] = (unsigned long long)pk2(x[j].x * r2, x[j].y * r2) | ((unsigned long long)pk2(x[j].z * r2, x[j].w * r2) << 32); }
    }
}
__device__ __forceinline__ float log_sigmoid_f(float z) {
    const float e = __expf(-fabsf(z));
    const float l1p = (e < 0.01f) ? e * (1.f - e * (0.5f - e * 0.33333333f)) : __logf(1.f + e);
    return fminf(z, 0.f) - l1p;
}
__device__ __forceinline__ void flog_naive(Frame& F, const float* b_f) {
    const int gw = F.vcu * NWAVES + F.wave, NGW = F.G * NWAVES;
    const bf16* XN = (const bf16*)(F.ws + WS_XN); const bf16* WF = (const bf16*)(F.ws + WS_WF); float* LOGF = (float*)(F.ws + WS_LOGF);
    for (int m = gw; m < M; m += NGW) {
        const GAS v4u* xr = (const GAS v4u*)(XN + (size_t)m * D) + 2 * F.lane; const v4u x0 = xr[0], x1 = xr[1];
        float xv[16];
        xv[0] = bflo(x0.x); xv[1] = bfhi(x0.x); xv[2] = bflo(x0.y); xv[3] = bfhi(x0.y); xv[4] = bflo(x0.z); xv[5] = bfhi(x0.z); xv[6] = bflo(x0.w); xv[7] = bfhi(x0.w);
        xv[8] = bflo(x1.x); xv[9] = bfhi(x1.x); xv[10] = bflo(x1.y); xv[11] = bfhi(x1.y); xv[12] = bflo(x1.z); xv[13] = bfhi(x1.z); xv[14] = bflo(x1.w); xv[15] = bfhi(x1.w);
        float mine = 0.f;
#pragma unroll
        for (int h = 0; h < NH; ++h) { const GAS v4u* wr = (const GAS v4u*)(WF + (size_t)h * D) + 2 * F.lane; const v4u w0 = wr[0], w1 = wr[1];
            float p = xv[0] * bflo(w0.x) + xv[1] * bfhi(w0.x) + xv[2] * bflo(w0.y) + xv[3] * bfhi(w0.y) + xv[4] * bflo(w0.z) + xv[5] * bfhi(w0.z) + xv[6] * bflo(w0.w) + xv[7] * bfhi(w0.w)
                    + xv[8] * bflo(w1.x) + xv[9] * bfhi(w1.x) + xv[10] * bflo(w1.y) + xv[11] * bfhi(w1.y) + xv[12] * bflo(w1.z) + xv[13] * bfhi(w1.z) + xv[14] * bflo(w1.w) + xv[15] * bfhi(w1.w);
            p = wave_sum(p); if (F.lane == h) mine = p; }
        if (F.lane < NH) LOGF[(size_t)m * NH + F.lane] = log_sigmoid_f(mine + b_f[F.lane]);
    }
}
__device__ __forceinline__ void headnorm_naive(Frame& F, const float* qg, const float* kg) {
    const int gw = F.vcu * NWAVES + F.wave, NGW = F.G * NWAVES;
    for (int it = gw; it < 2 * M; it += NGW) {
        const int which = it >= M ? 1 : 0, row = it - which * M;
        bf16* base = (bf16*)(F.ws + (which ? WS_K : WS_Q)) + (size_t)row * D; const float* gn = which ? kg : qg;
        GAS v4u* p = (GAS v4u*)base + 2 * F.lane; const v4u x0 = p[0], x1 = p[1];
        float v[16];
        v[0] = bflo(x0.x); v[1] = bfhi(x0.x); v[2] = bflo(x0.y); v[3] = bfhi(x0.y); v[4] = bflo(x0.z); v[5] = bfhi(x0.z); v[6] = bflo(x0.w); v[7] = bfhi(x0.w);
        v[8] = bflo(x1.x); v[9] = bfhi(x1.x); v[10] = bflo(x1.y); v[11] = bfhi(x1.y); v[12] = bflo(x1.z); v[13] = bfhi(x1.z); v[14] = bflo(x1.w); v[15] = bfhi(x1.w);
        float s = 0.f;
#pragma unroll
        for (int i = 0; i < 16; ++i) s += v[i] * v[i];
        s += __shfl_xor(s, 1); s += __shfl_xor(s, 2);
        float r = 1.0f / sqrtf(s * (1.f / HD) + EPS); if (!which) r *= C2;
        const int d0 = 16 * (F.lane & 3);
#pragma unroll
        for (int i = 0; i < 16; ++i) v[i] = v[i] * r * gn[d0 + i];
        v4u o0, o1; o0.x = pk2(v[0], v[1]); o0.y = pk2(v[2], v[3]); o0.z = pk2(v[4], v[5]); o0.w = pk2(v[6], v[7]);
        o1.x = pk2(v[8], v[9]); o1.y = pk2(v[10], v[11]); o1.z = pk2(v[12], v[13]); o1.w = pk2(v[14], v[15]);
        p[0] = o0; p[1] = o1;
    }
}
__device__ __forceinline__ void attn_naive(Frame& F) {
    LAS float* bias2 = (LAS float*)(F.lds);
    LAS unsigned char* Kt = F.lds + 8192; LAS unsigned char* Vt = F.lds + 16384; LAS float* wtot = (LAS float*)(F.lds + 24576);
    const float* LOGF = (const float*)(F.ws + WS_LOGF);
    const bf16* Qb = (const bf16*)(F.ws + WS_Q); const bf16* Kb = (const bf16*)(F.ws + WS_K); const bf16* Vb = (const bf16*)(F.ws + WS_V); const bf16* Gb = (const bf16*)(F.ws + WS_GT);
    bf16* Ob = (bf16*)(F.ws + WS_Q);
    for (int bh = F.vcu; bh < BATCH * NH; bh += F.G) {
        const int b = bh / NH, h = bh % NH;
        __syncthreads();
        {   const int t0 = 4 * F.tid; float lf0, lf1, lf2, lf3;
            lf0 = LOGF[((size_t)b * SEQ + t0 + 0) * NH + h]; lf1 = LOGF[((size_t)b * SEQ + t0 + 1) * NH + h]; lf2 = LOGF[((size_t)b * SEQ + t0 + 2) * NH + h]; lf3 = LOGF[((size_t)b * SEQ + t0 + 3) * NH + h];
            const float s1 = lf0 + lf1, s2 = s1 + lf2, s3 = s2 + lf3; float inc = s3;
#pragma unroll
            for (int o = 1; o < 64; o <<= 1) { const float v = __shfl_up(inc, o); if (F.lane >= o) inc += v; }
            if (F.lane == 63) wtot[F.wave] = inc;
            __syncthreads();
            float woff = 0.f; for (int w = 0; w < F.wave; ++w) woff += wtot[w];
            const float ex = inc - s3 + woff;
            bias2[t0] = -(ex + lf0) * LOG2E; bias2[t0 + 1] = -(ex + s1) * LOG2E; bias2[t0 + 2] = -(ex + s2) * LOG2E; bias2[t0 + 3] = -(ex + s3) * LOG2E;
        }
        __syncthreads();
        for (int qblk = 0; qblk < 4; ++qblk) {
            const int q = 512 * qblk + F.tid; const size_t R = (size_t)b * SEQ + q;
            float qv[64], o[64];
#pragma unroll
            for (int ch = 0; ch < 8; ++ch) { const v4u w = *(const GAS v4u*)(Qb + R * D + h * HD + 8 * ch);
                qv[8 * ch] = bflo(w.x); qv[8 * ch + 1] = bfhi(w.x); qv[8 * ch + 2] = bflo(w.y); qv[8 * ch + 3] = bfhi(w.y); qv[8 * ch + 4] = bflo(w.z); qv[8 * ch + 5] = bfhi(w.z); qv[8 * ch + 6] = bflo(w.w); qv[8 * ch + 7] = bfhi(w.w); }
#pragma unroll
            for (int d = 0; d < 64; ++d) o[d] = 0.f;
            float mx = -INFINITY, l = 0.f;
            const int ntile = 8 * (qblk + 1);
            for (int jt = 0; jt < ntile; ++jt) {
                __syncthreads();
                {   const int j = F.tid >> 3, ch = F.tid & 7; const size_t src = ((size_t)b * SEQ + 64 * jt + j) * D + h * HD + 8 * ch;
                    *(LAS v4u*)(Kt + j * 128 + ch * 16) = *(const GAS v4u*)(Kb + src); *(LAS v4u*)(Vt + j * 128 + ch * 16) = *(const GAS v4u*)(Vb + src); }
                __syncthreads();
                for (int j = 0; j < 64; ++j) {
                    const int s = 64 * jt + j;
                    if (s <= q) {
                        float dot = 0.f;
#pragma unroll
                        for (int ch = 0; ch < 8; ++ch) { const v4u w = *(const LAS v4u*)(Kt + j * 128 + ch * 16);
                            dot += qv[8 * ch] * bflo(w.x) + qv[8 * ch + 1] * bfhi(w.x) + qv[8 * ch + 2] * bflo(w.y) + qv[8 * ch + 3] * bfhi(w.y) + qv[8 * ch + 4] * bflo(w.z) + qv[8 * ch + 5] * bfhi(w.z) + qv[8 * ch + 6] * bflo(w.w) + qv[8 * ch + 7] * bfhi(w.w); }
                        const float sv = dot + bias2[s];
                        if (sv > mx) { const float al = __builtin_amdgcn_exp2f(mx - sv); l *= al;
#pragma unroll
                            for (int d = 0; d < 64; ++d) o[d] *= al;
                            mx = sv; }
                        const float p = __builtin_amdgcn_exp2f(sv - mx); l += p;
#pragma unroll
                        for (int ch = 0; ch < 8; ++ch) { const v4u w = *(const LAS v4u*)(Vt + j * 128 + ch * 16);
                            o[8 * ch] += p * bflo(w.x); o[8 * ch + 1] += p * bfhi(w.x); o[8 * ch + 2] += p * bflo(w.y); o[8 * ch + 3] += p * bfhi(w.y); o[8 * ch + 4] += p * bflo(w.z); o[8 * ch + 5] += p * bfhi(w.z); o[8 * ch + 6] += p * bflo(w.w); o[8 * ch + 7] += p * bfhi(w.w); }
                    }
                }
            }
            const float il = 1.0f / l;
#pragma unroll
            for (int ch = 0; ch < 8; ++ch) { const v4u g = *(const GAS v4u*)(Gb + R * D + h * HD + 8 * ch); v4u w;
                w.x = pk2(o[8 * ch] * il * sigm(bflo(g.x)), o[8 * ch + 1] * il * sigm(bfhi(g.x))); w.y = pk2(o[8 * ch + 2] * il * sigm(bflo(g.y)), o[8 * ch + 3] * il * sigm(bfhi(g.y)));
                w.z = pk2(o[8 * ch + 4] * il * sigm(bflo(g.z)), o[8 * ch + 5] * il * sigm(bfhi(g.z))); w.w = pk2(o[8 * ch + 6] * il * sigm(bflo(g.w)), o[8 * ch + 7] * il * sigm(bfhi(g.w)));
                *(GAS v4u*)(Ob + R * D + h * HD + 8 * ch) = w; }
        }
    }
}
__device__ __forceinline__ float gelu_tanh(float v) { return v * sigm(1.5957691216f * (v + 0.044715f * v * v * v)); }
__device__ __forceinline__ void s5_naive(Frame& F, const Args& A) {
    const int gw = F.vcu * NWAVES + F.wave, NGW = F.G * NWAVES;
    const bf16* U = (const bf16*)(F.ws + WS_U); bf16* Y = (bf16*)(F.ws + WS_Y);
    for (int item = gw; item < BATCH * NG; item += NGW) {
        const int b = item / NG, g = item % NG, p = F.lane;
        const float dt = __expf(A.in[7][g]);
        const float lr = A.in[8][g * NP + p], li = A.in[9][g * NP + p];
        const float mag = __expf(lr * dt);
        float rev = li * dt * 0.15915494309189535f; rev -= floorf(rev);
        const float a_re = mag * __builtin_amdgcn_cosf(rev), a_im = mag * __builtin_amdgcn_sinf(rev);
        const float den = lr * lr + li * li, nre = a_re - 1.f;
        const float z_re = (nre * lr + a_im * li) / den, z_im = (a_im * lr - nre * li) / den;
        float bbr[16], bbi[16], cr[16], ci[16];
#pragma unroll
        for (int c = 0; c < GC; ++c) { const float br = A.in[10][(size_t)(g * NP + p) * GC + c], bi = A.in[11][(size_t)(g * NP + p) * GC + c];
            bbr[c] = z_re * br - z_im * bi; bbi[c] = z_re * bi + z_im * br;
            cr[c] = A.in[12][(size_t)(g * GC + c) * NP + p]; ci[c] = A.in[13][(size_t)(g * GC + c) * NP + p]; }
        const int cw = (F.lane >> 2) & 15;
        const float dsk = A.in[14][g * GC + cw];
        float xr = 0.f, xi = 0.f;
        const bf16* up = U + (size_t)b * SEQ * D + g * GC; bf16* yp = Y + (size_t)b * SEQ * D + g * GC;
        v4u u0 = *(const GAS v4u*)up, u1 = *(const GAS v4u*)(up + 8); unsigned us = up[cw];
        for (int t = 0; t < SEQ; ++t) {
            const v4u c0 = u0, c1 = u1; const unsigned cs = us;
            if (t + 1 < SEQ) { u0 = *(const GAS v4u*)(up + (size_t)(t + 1) * D); u1 = *(const GAS v4u*)(up + (size_t)(t + 1) * D + 8); us = up[(size_t)(t + 1) * D + cw]; }
            float uv[16];
            uv[0] = bflo(c0.x); uv[1] = bfhi(c0.x); uv[2] = bflo(c0.y); uv[3] = bfhi(c0.y); uv[4] = bflo(c0.z); uv[5] = bfhi(c0.z); uv[6] = bflo(c0.w); uv[7] = bfhi(c0.w);
            uv[8] = bflo(c1.x); uv[9] = bfhi(c1.x); uv[10] = bflo(c1.y); uv[11] = bfhi(c1.y); uv[12] = bflo(c1.z); uv[13] = bfhi(c1.z); uv[14] = bflo(c1.w); uv[15] = bfhi(c1.w);
            float bur = 0.f, bui = 0.f;
#pragma unroll
            for (int c = 0; c < GC; ++c) { bur += bbr[c] * uv[c]; bui += bbi[c] * uv[c]; }
            const float nxr = a_re * xr - a_im * xi + bur, nxi = a_re * xi + a_im * xr + bui; xr = nxr; xi = nxi;
            float y[16];
#pragma unroll
            for (int c = 0; c < GC; ++c) y[c] = cr[c] * xr - ci[c] * xi;
            const bool b5 = (F.lane & 32) != 0, b4 = (F.lane & 16) != 0, b3 = (F.lane & 8) != 0, b2 = (F.lane & 4) != 0;
            float w8[8], w4[4], w2[2];
#pragma unroll
            for (int i = 0; i < 8; ++i) { const float send = b5 ? y[i] : y[i + 8], keep = b5 ? y[i + 8] : y[i]; w8[i] = keep + __shfl_xor(send, 32); }
#pragma unroll
            for (int i = 0; i < 4; ++i) { const float send = b4 ? w8[i] : w8[i + 4], keep = b4 ? w8[i + 4] : w8[i]; w4[i] = keep + __shfl_xor(send, 16); }
#pragma unroll
            for (int i = 0; i < 2; ++i) { const float send = b3 ? w4[i] : w4[i + 2], keep = b3 ? w4[i + 2] : w4[i]; w2[i] = keep + __shfl_xor(send, 8); }
            float w1; { const float send = b2 ? w2[0] : w2[1], keep = b2 ? w2[1] : w2[0]; w1 = keep + __shfl_xor(send, 4); }
            w1 += __shfl_xor(w1, 2); w1 += __shfl_xor(w1, 1);
            if ((F.lane & 3) == 0) { const float v = w1 + dsk * __builtin_bit_cast(float, cs << 16); yp[(size_t)t * D + cw] = (bf16)f2bf(gelu_tanh(v)); }
        }
    }
}

constexpr int NPH = 18;
typedef const __attribute__((address_space(4))) Args* KArgs;
template <class Epi, int N_, int K_>
__device__ __forceinline__ void run_gemm(Frame& F, const bf16* A, const bf16* Bt, const Epi& E) {
    pg8::Gemm g{A, Bt, M, N_, K_}; pg8::StaticOrder S; S.init(M, N_, F.G, (int)blockIdx.x);
    pg8::gemm_phase<Epi, pg8::StaticOrder, PG8_ALIGN, PG8_SP2>(F.lds + RING_OFF, g, S, E);
}
__global__ void __launch_bounds__(NWAVES * 64, 2) mk_fwd(Args args_unused) {
    extern __shared__ __attribute__((aligned(16))) unsigned char lds[];
    const KArgs kp0 = (KArgs)__builtin_amdgcn_kernarg_segment_ptr();
    Frame F;
    F.lds = (LAS unsigned char*)lds;
    F.MISC = (volatile LAS unsigned*)(F.lds + MISC_OFF);
    F.tid = threadIdx.x; F.lane = F.tid & 63; F.wave = __builtin_amdgcn_readfirstlane(F.tid >> 6);
    F.G = gridDim.x; { const int bx = blockIdx.x; F.vcu = (F.G % 8 == 0) ? (bx % 8) * (F.G / 8) + bx / 8 : bx; }
    F.ws = kp0->ws; F.out = kp0->out;
    F.ctl = (gu32*)(F.ws + WS_CTL);
    for (int u = F.tid; u < (LDS_BYTES - LDSCTL_OFF) / 4; u += NWAVES * 64) ((LAS unsigned*)(F.lds + LDSCTL_OFF))[u] = 0u;
    __syncthreads();
    const int lo = kp0->ph_lo, hi = kp0->ph_hi;
    XcdBarrier bar; bar.bar = (unsigned*)(F.ctl + CW_BAR); bar.x = 0; bar.st = nullptr;
    if (hi - lo > 1) bar = xcd_barrier_post((unsigned*)(F.ctl + CW_BAR), F.MISC + 8);
#define IN(k) (lo <= (k) && (k) < hi)
#define SEAM(k) do { if (IN(k) && IN((k) + 1)) xcd_barrier(bar); } while (0)
#define PHASE(k) if (IN(k)) { KArgs ap = kp0; asm volatile("" : "+s"(ap)); unsigned char* ws = ap->ws; F.ws = ws; F.out = ap->out; (void)ws;
#define ENDPHASE(k) } SEAM(k);
    PHASE(0) { Args a; for (int i = 0; i < 24; ++i) a.in[i] = ap->in[i]; a.out = ap->out; a.ws = ws; a.ph_lo = 0; a.ph_hi = 0; p0_prologue(F, a); } ENDPHASE(0)
    PHASE(1) flog_naive(F, ap->in[2]); ENDPHASE(1)
    PHASE(2) { pg8::EpiBf16<0> E{(bf16*)(ws + WS_Q), D, nullptr, D, (size_t)(WS_K - WS_Q) / 2, 1.0f};
               run_gemm<pg8::EpiBf16<0>, 4 * D, D>(F, (const bf16*)(ws + WS_XN), (const bf16*)(ws + WS_WFOX), E); } ENDPHASE(2)
    PHASE(3) headnorm_naive(F, ap->in[3], ap->in[4]); ENDPHASE(3)
    PHASE(4) attn_naive(F); ENDPHASE(4)
    PHASE(5) { pg8::EpiF32 E{(float*)(ws + WS_SCR), D}; run_gemm<pg8::EpiF32, D, D>(F, (const bf16*)(ws + WS_Q), (const bf16*)(ws + WS_WFO), E); } ENDPHASE(5)
    PHASE(6) nr_pass(F, (const float*)(ws + WS_SCR), ap->in[0], ap->in[18], ap->out, (bf16*)(ws + WS_XN)); ENDPHASE(6)
    PHASE(7) { pg8::EpiSwiGLU E{(bf16*)(ws + WS_H), FF}; run_gemm<pg8::EpiSwiGLU, 2 * FF, D>(F, (const bf16*)(ws + WS_XN), (const bf16*)(ws + WS_WGU0), E); } ENDPHASE(7)
    PHASE(8) { pg8::EpiF32 E{(float*)(ws + WS_SCR), D}; run_gemm<pg8::EpiF32, D, FF>(F, (const bf16*)(ws + WS_H), (const bf16*)(ws + WS_WD0), E); } ENDPHASE(8)
    PHASE(9) nr_pass(F, (const float*)(ws + WS_SCR), ap->out, ap->in[20], ap->out, (bf16*)(ws + WS_XN)); ENDPHASE(9)
    PHASE(10) { pg8::EpiBf16<0> E{(bf16*)(ws + WS_U), D, nullptr, 0, 0, 1.0f}; run_gemm<pg8::EpiBf16<0>, D, D>(F, (const bf16*)(ws + WS_XN), (const bf16*)(ws + WS_WSI), E); } ENDPHASE(10)
    PHASE(11) { Args a; for (int i = 0; i < 24; ++i) a.in[i] = ap->in[i]; a.out = ap->out; a.ws = ws; a.ph_lo = 0; a.ph_hi = 0; s5_naive(F, a); } ENDPHASE(11)
    PHASE(12) { pg8::EpiGlu E{(const bf16*)(ws + WS_Y), (bf16*)(ws + WS_Z), D}; run_gemm<pg8::EpiGlu, D, D>(F, (const bf16*)(ws + WS_Y), (const bf16*)(ws + WS_WSG), E); } ENDPHASE(12)
    PHASE(13) { pg8::EpiF32 E{(float*)(ws + WS_SCR), D}; run_gemm<pg8::EpiF32, D, D>(F, (const bf16*)(ws + WS_Z), (const bf16*)(ws + WS_WSO), E); } ENDPHASE(13)
    PHASE(14) nr_pass(F, (const float*)(ws + WS_SCR), ap->out, ap->in[18] + D, ap->out, (bf16*)(ws + WS_XN)); ENDPHASE(14)
    PHASE(15) { pg8::EpiSwiGLU E{(bf16*)(ws + WS_H), FF}; run_gemm<pg8::EpiSwiGLU, 2 * FF, D>(F, (const bf16*)(ws + WS_XN), (const bf16*)(ws + WS_WGU1), E); } ENDPHASE(15)
    PHASE(16) { pg8::EpiF32 E{(float*)(ws + WS_SCR), D}; run_gemm<pg8::EpiF32, D, FF>(F, (const bf16*)(ws + WS_H), (const bf16*)(ws + WS_WD1), E); } ENDPHASE(16)
    PHASE(17) nr_pass(F, (const float*)(ws + WS_SCR), ap->out, ap->in[20] + D, ap->out, nullptr); ENDPHASE(17)
#undef IN
#undef SEAM
#undef PHASE
#undef ENDPHASE
}

extern "C" void kernel_launch(void* const* d_in, const int* in_sizes, int n_in, void* d_out, int out_size, void* d_ws, size_t ws_size, hipStream_t stream) {
    static int grid = 0;
    if (grid == 0) {
        if (n_in != 24 || in_sizes[0] != M * D || out_size != M * D || ws_size < WS_END) { fprintf(stderr, "kernel_launch: shape/workspace mismatch (n_in %d, in0 %d, out %d, ws %zu)\n", n_in, n_in > 0 ? in_sizes[0] : -1, out_size, ws_size); grid = -1; return; }
        int dev = 0, cus = 0;
        if (hipGetDevice(&dev) != hipSuccess || hipDeviceGetAttribute(&cus, hipDeviceAttributeMultiprocessorCount, dev) != hipSuccess) { grid = -1; return; }
        if (hipFuncSetAttribute((const void*)mk_fwd, hipFuncAttributeMaxDynamicSharedMemorySize, LDS_BYTES) != hipSuccess) { fprintf(stderr, "kernel_launch: hipFuncSetAttribute failed\n"); grid = -1; return; }
        (void)hipGetLastError();
        grid = cus;
    }
    if (grid < 0) return;
    if (hipMemsetAsync((char*)d_ws + WS_CTL, 0, CTL_ZERO_BYTES, stream) != hipSuccess) return;
    Args a{};
    for (int i = 0; i < 24; ++i) a.in[i] = (const float*)d_in[i];
    a.out = (float*)d_out; a.ws = (unsigned char*)d_ws;
#if MK_ONE_LAUNCH
    a.ph_lo = 0; a.ph_hi = NPH;
    hipLaunchKernelGGL(mk_fwd, dim3(grid), dim3(NWAVES * 64), LDS_BYTES, stream, a);
#else
    for (int ph = 0; ph < NPH; ++ph) { a.ph_lo = ph; a.ph_hi = ph + 1; hipLaunchKernelGGL(mk_fwd, dim3(grid), dim3(NWAVES * 64), LDS_BYTES, stream, a); }
#endif
}
```

```cpp
#include <hip/hip_runtime.h>
#include <hip/hip_bf16.h>
#include <cstdio>
#include <cstdint>
namespace pg8 {
#define PG8_LAS __attribute__((address_space(3)))
typedef unsigned short bf16_t;
typedef short bf16x8 __attribute__((ext_vector_type(8)));
typedef float f32x4 __attribute__((ext_vector_type(4)));
typedef unsigned u32x4 __attribute__((ext_vector_type(4)));
constexpr int BM = 256, BK = 64, HALF = 128, HTB = HALF * BK * 2  , STAGE_BYTES = 8 * HTB, NXCD = 8, WGM = 8;

__host__ __device__ __forceinline__ int lds_byte(int r, int c) { const int st = (r >> 4) * 2 + (c >> 5), rr = r & 15, cc = c & 31, ob = rr * 64 + cc * 2; return st * 1024 + (ob ^ (((ob >> 9) & 1) << 5)); }
__host__ __device__ __forceinline__ void stage_rc(int b, int& R, int& C) { const int st = b / 1024, sb = b % 1024, swz = sb ^ (((sb >> 9) & 1) << 5); R = (st >> 1) * 16 + swz / 64; C = (st & 1) * 32 + (swz % 64) / 2; }
__host__ __device__ __forceinline__ int perm32(int rho) { const int n = rho >> 4, i = rho & 15; return 8 * (i >> 2) + 4 * n + (i & 3); }

struct Unit { int pm, pn; };
struct Gemm { const bf16_t* A; const bf16_t* Bt; int M, N, K; };

struct StaticOrder {
    int nM, nN, nwg, G, c;
    __host__ __device__ void init(int M, int N, int G_, int c_) { nM = M / BM; nN = N / BM; nwg = nM * nN; G = G_; c = c_; }
    __host__ __device__ bool next(int i, Unit& u) const {
        const long L = (long)i * G + c; if (L >= nwg) return false;
        int wgid = (int)L; { const int q = nwg / NXCD, r = nwg % NXCD, xcd = wgid % NXCD, off = wgid / NXCD; wgid = (xcd < r ? xcd * (q + 1) : r * (q + 1) + (xcd - r) * q) + off; }
        const int nig = WGM * nN, gid = wgid / nig, fm = gid * WGM, gsz = (nM - fm) < WGM ? (nM - fm) : WGM;
        u.pm = fm + ((wgid % nig) % gsz); u.pn = (wgid % nig) / gsz; return true;
    }
    __device__ __forceinline__ void a_ready(const Unit&) const {}
    __device__ __forceinline__ void done(const Unit&) const {}
};

__device__ __forceinline__ unsigned cvt_pk_bf16(float lo, float hi) { unsigned r; asm volatile("v_cvt_pk_bf16_f32 %0, %1, %2" : "=v"(r) : "v"(lo), "v"(hi)); return r; }
typedef float f32x2 __attribute__((ext_vector_type(2)));
__device__ __forceinline__ f32x2 gelu_pk(f32x2 v) {
    const f32x2 av = __builtin_elementwise_abs(v), d = av * 0.2316418882f + 1.0f;
    f32x2 t; t.x = __builtin_amdgcn_rcpf(d.x); t.y = __builtin_amdgcn_rcpf(d.y);
    f32x2 q = t * 0.5307027145f + (-0.7265760135f); q = q * t + 0.7107068705f; q = q * t + (-0.142248368f); q = q * t + 0.127414796f; q = q * t;
    const f32x2 s = (v * v) * (-0.72134752044f);
    f32x2 e; e.x = __builtin_amdgcn_exp2f(s.x); e.y = __builtin_amdgcn_exp2f(s.y);
    const f32x2 m = v * (q * e), r = v - m;
    f32x2 o; o.x = v.x < 0.f ? m.x : r.x; o.y = v.y < 0.f ? m.y : r.y; return o;
}

template <int ACT  > struct EpiBf16 {
    static constexpr bool PERM = true, AFTER_DRAIN = false; static_assert(ACT == 0 || ACT == 1, "EpiBf16: ACT is 0 (none) or 1 (gelu_pk)");
    bf16_t* O; int ldc; const float* bias; int split_cols; size_t split_stride; float scale0;
    __device__ __forceinline__ void operator()(const f32x4 (&acc)[2][2][4][2], const Unit& u, int wr, int wc, int fr, int fq) const {
        const int row0 = u.pm * BM + wr * 64 + fr; int colt = u.pn * BM; bf16_t* base = O;
        float sc = 1.f; if (split_cols) { const int t = colt / split_cols; base += (size_t)t * split_stride; colt -= t * split_cols; if (t == 0) sc = scale0; }
        const int col0 = colt + wc * 32 + 8 * fq, bcol0 = u.pn * BM + wc * 32 + 8 * fq;
        f32x4 bv[2][2];
#pragma unroll
        for (int bj = 0; bj < 2; ++bj)
#pragma unroll
            for (int n = 0; n < 2; ++n) bv[bj][n] = bias ? *(const f32x4*)(bias + bcol0 + bj * HALF + 4 * n) : (f32x4){0.f, 0.f, 0.f, 0.f};
#pragma unroll
        for (int ai = 0; ai < 2; ++ai)
#pragma unroll
            for (int m = 0; m < 4; ++m) { bf16_t* rowp = base + (size_t)(row0 + ai * HALF + m * 16) * ldc + col0;
#pragma unroll
                for (int bj = 0; bj < 2; ++bj) { f32x4 v0 = acc[ai][bj][m][0] + bv[bj][0], v1 = acc[ai][bj][m][1] + bv[bj][1];
                    if (ACT == 1) { f32x2 a = gelu_pk((f32x2){v0[0], v0[1]}), b = gelu_pk((f32x2){v0[2], v0[3]}), c = gelu_pk((f32x2){v1[0], v1[1]}), d = gelu_pk((f32x2){v1[2], v1[3]});
                        v0 = (f32x4){a.x, a.y, b.x, b.y}; v1 = (f32x4){c.x, c.y, d.x, d.y}; }
                    v0 = v0 * sc; v1 = v1 * sc; u32x4 w; w.x = cvt_pk_bf16(v0[0], v0[1]); w.y = cvt_pk_bf16(v0[2], v0[3]); w.z = cvt_pk_bf16(v1[0], v1[1]); w.w = cvt_pk_bf16(v1[2], v1[3]);
                    *(u32x4*)(rowp + bj * HALF) = w; } }
    }
};

struct PanelStats {
    unsigned* xbuf;
    unsigned* cnt;
    unsigned* tmo;
    int ntn; float eps;
    unsigned code;
    __device__ __forceinline__ bool run(const f32x4 (&v)[2][2][4][2], const Unit& u, int wr, int wc, int fr, int fq, PG8_LAS unsigned char* lds, int wid, int lane) const {
        typedef float f32x2v __attribute__((ext_vector_type(2)));
        PG8_LAS f32x2v* P = (PG8_LAS f32x2v*)lds;
        PG8_LAS f32x2v* S = (PG8_LAS f32x2v*)(lds + 8192);
        PG8_LAS unsigned* flag = (PG8_LAS unsigned*)(lds + 8192 + 2048);
#pragma unroll
        for (int ai = 0; ai < 2; ++ai)
#pragma unroll
            for (int m = 0; m < 4; ++m) {
                float s = 0.f;
#pragma unroll
                for (int bj = 0; bj < 2; ++bj)
#pragma unroll
                    for (int n = 0; n < 2; ++n) { const f32x4 x = v[ai][bj][m][n]; s += (x[0] + x[1]) + (x[2] + x[3]); }
                s += __shfl_xor(s, 16); s += __shfl_xor(s, 32);
                const float mw = s * (1.0f / 64.0f); float q = 0.f;
#pragma unroll
                for (int bj = 0; bj < 2; ++bj)
#pragma unroll
                    for (int n = 0; n < 2; ++n) { const f32x4 d = v[ai][bj][m][n] - mw; q += (d[0] * d[0] + d[1] * d[1]) + (d[2] * d[2] + d[3] * d[3]); }
                q += __shfl_xor(q, 16); q += __shfl_xor(q, 32);
                if (fq == 0) P[(ai * HALF + wr * 64 + m * 16 + fr) * 4 + wc] = (f32x2v){mw, q};
            }
        asm volatile("s_waitcnt lgkmcnt(0)" ::: "memory"); __builtin_amdgcn_s_barrier(); asm volatile("" ::: "memory");
#if defined(BROKEN_EXCHANGE_NO_WAIT)
#warning BROKEN CONTROL BUILD: the row-statistics exchange does not wait; results are wrong by design
        if (blockIdx.x >= 64) { const long long t0_ = clock64(); while (clock64() - t0_ < 60000) __builtin_amdgcn_s_sleep(8); }
#endif
        const int row = wid * 32 + (lane & 31);
        if (lane < 32) {
            const f32x2v a = P[row * 4 + 0], b = P[row * 4 + 1], c = P[row * 4 + 2], d = P[row * 4 + 3];
            const float mt = (a.x + b.x + c.x + d.x) * 0.25f;
            const float da = a.x - mt, db = b.x - mt, dc = c.x - mt, dd = d.x - mt;
            const float m2 = (a.y + b.y) + (c.y + d.y) + 64.0f * ((da * da + db * db) + (dc * dc + dd * dd));
            unsigned long long* slot = (unsigned long long*)xbuf + ((size_t)(u.pm * BM + row) * 4 + u.pn);
            __hip_atomic_store(slot, ((unsigned long long)__float_as_uint(m2) << 32) | __float_as_uint(mt), __ATOMIC_RELAXED, __HIP_MEMORY_SCOPE_AGENT);
        }
        asm volatile("s_waitcnt vmcnt(0)" ::: "memory");
        if (lane == 0) __hip_atomic_fetch_add(cnt + 64 * u.pm, 1u, __ATOMIC_RELAXED, __HIP_MEMORY_SCOPE_AGENT);
        if (wid == 0) {
            bool dead = false; const unsigned long long t0 = __builtin_amdgcn_s_memrealtime(); const unsigned want = 8u * (unsigned)ntn;
            for (;;) {
#if defined(BROKEN_EXCHANGE_NO_WAIT)
                break;
#endif
                if ((unsigned)__builtin_amdgcn_readfirstlane(__hip_atomic_load(cnt + 64 * u.pm, __ATOMIC_RELAXED, __HIP_MEMORY_SCOPE_AGENT)) >= want) break;
                if (__builtin_amdgcn_s_memrealtime() - t0 > 2000000ull) {
                    if (lane == 0) { unsigned expect = 0u; __hip_atomic_compare_exchange_strong(tmo + 1, &expect, code | (unsigned)(u.pm & 0xff), __ATOMIC_RELAXED, __ATOMIC_RELAXED, __HIP_MEMORY_SCOPE_AGENT);
                                     __hip_atomic_store(tmo, 1u, __ATOMIC_RELAXED, __HIP_MEMORY_SCOPE_AGENT); }
                    dead = true; break; }
                __builtin_amdgcn_s_sleep(2);
            }
            __builtin_amdgcn_fence(__ATOMIC_ACQUIRE, "agent");
            if (lane == 0) flag[0] = dead ? 1u : 0u;
        }
        asm volatile("s_waitcnt vmcnt(0) lgkmcnt(0)" ::: "memory"); __builtin_amdgcn_s_barrier(); asm volatile("" ::: "memory");
        const bool bad = flag[0] != 0u;
        if (lane < 32) {
            const unsigned long long* slot = (const unsigned long long*)xbuf + (size_t)(u.pm * BM + row) * 4; float mt[4], m2[4]; float ms = 0.f;
#pragma unroll
            for (int t = 0; t < 4; ++t) { if (t < ntn) { const unsigned long long w = __hip_atomic_load(slot + t, __ATOMIC_RELAXED, __HIP_MEMORY_SCOPE_AGENT); mt[t] = __uint_as_float((unsigned)w); m2[t] = __uint_as_float((unsigned)(w >> 32)); } else { mt[t] = 0.f; m2[t] = 0.f; } ms += mt[t]; }
            const float mean = ms / (float)ntn; float q = 0.f;
#pragma unroll
            for (int t = 0; t < 4; ++t) if (t < ntn) { const float dm = mt[t] - mean; q += m2[t] + 256.0f * dm * dm; }
            S[row] = (f32x2v){mean, 1.0f / sqrtf(q / (256.0f * (float)ntn) + eps)};
        }
        asm volatile("s_waitcnt lgkmcnt(0)" ::: "memory"); __builtin_amdgcn_s_barrier(); asm volatile("" ::: "memory");
        return bad;
    }
};
struct EpiLnRes {
    static constexpr bool PERM = false, AFTER_DRAIN = true;
    const float* base; float* out; int ldc; const float* bias; PanelStats st; unsigned poison;
    __device__ __forceinline__ void fused(f32x4 (&acc)[2][2][4][2], const Unit& u, int wr, int wc, int fr, int fq, PG8_LAS unsigned char* lds, int wid, int lane) const {
        typedef float f32x2v __attribute__((ext_vector_type(2)));
        const PG8_LAS f32x2v* S = (const PG8_LAS f32x2v*)(lds + 8192);
        const int col0 = u.pn * BM + wc * 32 + 4 * fq;
#pragma unroll
        for (int bj = 0; bj < 2; ++bj)
#pragma unroll
            for (int n = 0; n < 2; ++n) { const f32x4 bv = bias ? *(const f32x4*)(bias + col0 + bj * HALF + n * 16) : (f32x4){0.f, 0.f, 0.f, 0.f};
#pragma unroll
                for (int ai = 0; ai < 2; ++ai)
#pragma unroll
                    for (int m = 0; m < 4; ++m) acc[ai][bj][m][n] += bv; }
        f32x4 pre[4][2][2];
#pragma unroll
        for (int m = 0; m < 4; ++m) { const size_t off = (size_t)(u.pm * BM + wr * 64 + m * 16 + fr) * ldc + col0;
#pragma unroll
            for (int bj = 0; bj < 2; ++bj)
#pragma unroll
                for (int n = 0; n < 2; ++n) pre[m][bj][n] = *(const f32x4*)(base + off + bj * HALF + n * 16); }
        const bool bad = st.run(acc, u, wr, wc, fr, fq, lds, wid, lane) || poison != 0u;
        const float qnan = __builtin_nanf("");
#pragma unroll
        for (int ai = 0; ai < 2; ++ai)
#pragma unroll
            for (int m = 0; m < 4; ++m) { const int r = ai * HALF + wr * 64 + m * 16 + fr; const f32x2v sr = S[r]; const size_t off = (size_t)(u.pm * BM + r) * ldc + col0;
#pragma unroll
                for (int bj = 0; bj < 2; ++bj)
#pragma unroll
                    for (int n = 0; n < 2; ++n) { const f32x4 bs = ai == 0 ? pre[m][bj][n] : *(const f32x4*)(base + off + bj * HALF + n * 16); f32x4 o = bs + (acc[ai][bj][m][n] - sr.x) * sr.y;
                        if (bad) o = (f32x4){qnan, qnan, qnan, qnan}; *(f32x4*)(out + off + bj * HALF + n * 16) = o; }
                if (m & 1) asm volatile("" ::: "memory"); }
    }
};
struct EpiLnResLn {
    static constexpr bool PERM = false, AFTER_DRAIN = true;
    const float* base; float* out; bf16_t* xn; int ldc; const float* bias; PanelStats st1, st2; unsigned poison;
    __device__ __forceinline__ void fused(f32x4 (&acc)[2][2][4][2], const Unit& u, int wr, int wc, int fr, int fq, PG8_LAS unsigned char* lds, int wid, int lane) const {
        typedef float f32x2v __attribute__((ext_vector_type(2))); typedef unsigned u32x2v __attribute__((ext_vector_type(2)));
        const PG8_LAS f32x2v* S = (const PG8_LAS f32x2v*)(lds + 8192);
        const int col0 = u.pn * BM + wc * 32 + 4 * fq;
#pragma unroll
        for (int bj = 0; bj < 2; ++bj)
#pragma unroll
            for (int n = 0; n < 2; ++n) { const f32x4 bv = bias ? *(const f32x4*)(bias + col0 + bj * HALF + n * 16) : (f32x4){0.f, 0.f, 0.f, 0.f};
#pragma unroll
                for (int ai = 0; ai < 2; ++ai)
#pragma unroll
                    for (int m = 0; m < 4; ++m) acc[ai][bj][m][n] += bv; }
        bool bad = st1.run(acc, u, wr, wc, fr, fq, lds, wid, lane) || poison != 0u;
        const float qnan = __builtin_nanf("");
#pragma unroll
        for (int ai = 0; ai < 2; ++ai)
#pragma unroll
            for (int m = 0; m < 4; ++m) { const int r = ai * HALF + wr * 64 + m * 16 + fr; const f32x2v sr = S[r]; const size_t off = (size_t)(u.pm * BM + r) * ldc + col0;
#pragma unroll
                for (int bj = 0; bj < 2; ++bj)
#pragma unroll
                    for (int n = 0; n < 2; ++n) { const f32x4 bs = *(const f32x4*)(base + off + bj * HALF + n * 16); acc[ai][bj][m][n] = bs + (acc[ai][bj][m][n] - sr.x) * sr.y; }
                asm volatile("" : "+v"(acc[ai][0][m][0]), "+v"(acc[ai][0][m][1]), "+v"(acc[ai][1][m][0]), "+v"(acc[ai][1][m][1]));
                if (m & 1) asm volatile("" ::: "memory"); }
        const bool bad1 = bad;
        bad = st2.run(acc, u, wr, wc, fr, fq, lds, wid, lane) || bad;
#pragma unroll
        for (int ai = 0; ai < 2; ++ai)
#pragma unroll
            for (int m = 0; m < 4; ++m) { const int r = ai * HALF + wr * 64 + m * 16 + fr; const f32x2v sr = S[r]; const size_t off = (size_t)(u.pm * BM + r) * ldc + col0;
#pragma unroll
                for (int bj = 0; bj < 2; ++bj)
#pragma unroll
                    for (int n = 0; n < 2; ++n) { const f32x4 x1 = acc[ai][bj][m][n]; *(f32x4*)(out + off + bj * HALF + n * 16) = bad1 ? (f32x4){qnan, qnan, qnan, qnan} : x1;
                        const f32x4 o = (x1 - sr.x) * sr.y; u32x2v w; w.x = cvt_pk_bf16(o[0], o[1]); w.y = cvt_pk_bf16(o[2], o[3]);
                        if (bad) { w.x = 0x7fc07fc0u; w.y = 0x7fc07fc0u; } *(u32x2v*)(xn + off + bj * HALF + n * 16) = w; }
                asm volatile("" ::: "memory"); }
    }
};

template <class Epi, class Sched, bool ALIGN_EPI = false, bool SP2 = false>
__device__ __forceinline__ void gemm_phase(PG8_LAS unsigned char* lds, const Gemm g, const Sched& S, const Epi& E) {
    const int tid = threadIdx.x, wid = __builtin_amdgcn_readfirstlane(tid >> 6), lane = tid & 63, wr = wid >> 2, wc = wid & 3, fr = lane & 15, fq = lane >> 4;
    const int K = g.K, nt = K / BK;
    unsigned voffA[2], voffB[2];
#pragma unroll
    for (int i = 0; i < 2; ++i) { int R, C; stage_rc(tid * 16 + i * 8192, R, C); const int Rb = Epi::PERM ? ((R & ~31) + perm32(R & 31)) : R;
        voffA[i] = (unsigned)(R * K + C) * 2u; voffB[i] = (unsigned)(Rb * K + C) * 2u; }
    const size_t kstep = (size_t)(BK * 2);
    const size_t hstep = (size_t)HALF * K * 2;
    const size_t tstep = 2 * hstep;
    const unsigned ldsw = (unsigned)wid * 1024u;
    const int aoff = lds_byte(wr * 64 + fr, fq * 8), boff = lds_byte(wc * 32 + fr, fq * 8);
#define PG8_SA(b, h) (((b) * 2 + (h)) * HTB)
#define PG8_SB(b, h) ((4 + (b) * 2 + (h)) * HTB)
#define PG8_STAGE(bufoff, gbase, voff) do { _Pragma("unroll") for (int _i = 0; _i < 2; ++_i) \
        __builtin_amdgcn_global_load_lds((const unsigned*)((const char*)(gbase) + (voff)[_i]), (PG8_LAS unsigned*)(lds + (bufoff) + ldsw + _i * 8192), 16, 0, 0); } while (0)
#define PG8_LDA(dst, b, h) do { _Pragma("unroll") for (int m = 0; m < 4; ++m) _Pragma("unroll") for (int k = 0; k < 2; ++k) dst[m][k] = *(const PG8_LAS bf16x8*)(lds + PG8_SA(b, h) + aoff + m * 2048 + k * 1024); } while (0)
#define PG8_LDB(dst, b, h) do { _Pragma("unroll") for (int n = 0; n < 2; ++n) _Pragma("unroll") for (int k = 0; k < 2; ++k) dst[n][k] = *(const PG8_LAS bf16x8*)(lds + PG8_SB(b, h) + boff + n * 2048 + k * 1024); } while (0)
#define PG8_MMA(ai, bj, At, Bt) do { __builtin_amdgcn_s_setprio(1); _Pragma("unroll") for (int m = 0; m < 4; ++m) _Pragma("unroll") for (int n = 0; n < 2; ++n) _Pragma("unroll") for (int k = 0; k < 2; ++k) \
        acc[ai][bj][m][n] = __builtin_amdgcn_mfma_f32_16x16x32_bf16(Bt[n][k], At[m][k], acc[ai][bj][m][n], 0, 0, 0); __builtin_amdgcn_s_setprio(0); } while (0)
#define PG8_WAIT_V(n) asm volatile("s_waitcnt vmcnt(" #n ")" ::: "memory")
#define PG8_WAIT_L(n) asm volatile("s_waitcnt lgkmcnt(" #n ")" ::: "memory")
#define PG8_BAR __builtin_amdgcn_s_barrier()
#define PG8_SCHED __builtin_amdgcn_sched_barrier(0)
    Unit cur, nxt; int ui = 0;
    if (!S.next(0, cur)) return;
    f32x4 acc[2][2][4][2];
#pragma unroll
    for (int a = 0; a < 2; ++a)
#pragma unroll
        for (int b = 0; b < 2; ++b)
#pragma unroll
            for (int m = 0; m < 4; ++m)
#pragma unroll
                for (int n = 0; n < 2; ++n) acc[a][b][m][n] = (f32x4){0.f, 0.f, 0.f, 0.f};
    bf16x8 At[4][2], B0[2][2], B1[2][2];
    const char* cA = (const char*)g.A + (size_t)cur.pm * tstep; const char* cB = (const char*)g.Bt + (size_t)cur.pn * tstep;
    S.a_ready(cur);
    if constexpr (SP2) {
        PG8_STAGE(PG8_SB(0, 0), cB, voffB); PG8_STAGE(PG8_SB(0, 1), cB + hstep, voffB); PG8_STAGE(PG8_SA(0, 0), cA, voffA); PG8_STAGE(PG8_SA(0, 1), cA + hstep, voffA);
        if (wr == 1) PG8_BAR;
        PG8_WAIT_V(2); PG8_BAR;
        PG8_STAGE(PG8_SB(1, 0), cB + kstep, voffB); PG8_STAGE(PG8_SA(1, 0), cA + kstep, voffA); PG8_STAGE(PG8_SB(1, 1), cB + hstep + kstep, voffB);
        PG8_WAIT_V(6); PG8_BAR;
    } else {
        PG8_STAGE(PG8_SB(0, 0), cB, voffB); PG8_STAGE(PG8_SA(0, 0), cA, voffA); PG8_STAGE(PG8_SB(0, 1), cB + hstep, voffB); PG8_STAGE(PG8_SA(0, 1), cA + hstep, voffA);
        if (wr == 1) PG8_BAR;
        PG8_WAIT_V(4); PG8_BAR;
        PG8_STAGE(PG8_SB(1, 0), cB + kstep, voffB); PG8_STAGE(PG8_SA(1, 0), cA + kstep, voffA); PG8_STAGE(PG8_SB(1, 1), cB + hstep + kstep, voffB);
        PG8_WAIT_V(6); PG8_BAR;
    }
    for (;;) {
        const bool has_next = S.next(ui + 1, nxt);
        const char* nA = has_next ? (const char*)g.A + (size_t)nxt.pm * tstep : cA; const char* nB = has_next ? (const char*)g.Bt + (size_t)nxt.pn * tstep : cB;
        for (int t = 0; t < nt; t += 2) {
            const bool last = (t == nt - 2);
            const char* a1 = cA + (size_t)(t + 1) * kstep;
            const char* a2 = last ? nA : cA + (size_t)(t + 2) * kstep; const char* b2 = last ? nB : cB + (size_t)(t + 2) * kstep;
            const char* a3 = a2 + kstep; const char* b3 = b2 + kstep;
            if (last && has_next) S.a_ready(nxt);
            if constexpr (SP2) {
            PG8_LDB(B0, 0, 0); PG8_LDB(B1, 0, 1); PG8_SCHED; PG8_LDA(At, 0, 0); PG8_STAGE(PG8_SA(1, 1), a1 + hstep, voffA);
            PG8_WAIT_V(8); PG8_WAIT_L(0); PG8_BAR; PG8_MMA(0, 0, At, B0); PG8_MMA(0, 1, At, B1); PG8_BAR; PG8_SCHED;
            PG8_LDA(At, 0, 1); PG8_STAGE(PG8_SB(0, 0), b2, voffB); PG8_STAGE(PG8_SB(0, 1), b2 + hstep, voffB); PG8_STAGE(PG8_SA(0, 0), a2, voffA);
            PG8_WAIT_V(8); PG8_WAIT_L(0); PG8_BAR; PG8_MMA(1, 0, At, B0); PG8_MMA(1, 1, At, B1); PG8_BAR; PG8_SCHED;
            PG8_LDB(B0, 1, 0); PG8_LDB(B1, 1, 1); PG8_SCHED; PG8_LDA(At, 1, 0); PG8_STAGE(PG8_SA(0, 1), a2 + hstep, voffA);
            PG8_WAIT_V(8); PG8_WAIT_L(0); PG8_BAR; PG8_MMA(0, 0, At, B0); PG8_MMA(0, 1, At, B1); PG8_BAR; PG8_SCHED;
            PG8_LDA(At, 1, 1); PG8_STAGE(PG8_SB(1, 0), b3, voffB); PG8_STAGE(PG8_SB(1, 1), b3 + hstep, voffB); PG8_STAGE(PG8_SA(1, 0), a3, voffA);
            PG8_WAIT_V(8); PG8_WAIT_L(0); PG8_BAR; PG8_MMA(1, 0, At, B0); PG8_MMA(1, 1, At, B1); PG8_BAR; PG8_SCHED;
            } else {
            PG8_LDB(B0, 0, 0); PG8_SCHED; PG8_LDA(At, 0, 0); PG8_STAGE(PG8_SA(1, 1), a1 + hstep, voffA);
            PG8_WAIT_L(8); PG8_BAR; PG8_WAIT_L(0); PG8_MMA(0, 0, At, B0); PG8_BAR; PG8_SCHED;
            PG8_LDB(B1, 0, 1); PG8_STAGE(PG8_SB(0, 0), b2, voffB);
            PG8_BAR; PG8_WAIT_L(0); PG8_MMA(0, 1, At, B1); PG8_BAR;
            PG8_LDA(At, 0, 1); PG8_STAGE(PG8_SA(0, 0), a2, voffA);
            PG8_BAR; PG8_WAIT_L(0); PG8_MMA(1, 0, At, B0); PG8_BAR; PG8_SCHED;
            PG8_STAGE(PG8_SB(0, 1), b2 + hstep, voffB);
            PG8_WAIT_V(6); PG8_BAR; PG8_MMA(1, 1, At, B1); PG8_BAR;
            PG8_LDB(B0, 1, 0); PG8_SCHED; PG8_LDA(At, 1, 0); PG8_STAGE(PG8_SA(0, 1), a2 + hstep, voffA);
            PG8_WAIT_L(8); PG8_BAR; PG8_WAIT_L(0); PG8_MMA(0, 0, At, B0); PG8_BAR; PG8_SCHED;
            PG8_LDB(B1, 1, 1); PG8_STAGE(PG8_SB(1, 0), b3, voffB);
            PG8_BAR; PG8_WAIT_L(0); PG8_MMA(0, 1, At, B1); PG8_BAR;
            PG8_LDA(At, 1, 1); PG8_STAGE(PG8_SA(1, 0), a3, voffA);
            PG8_BAR; PG8_WAIT_L(0); PG8_MMA(1, 0, At, B0); PG8_BAR; PG8_SCHED;
            PG8_STAGE(PG8_SB(1, 1), b3 + hstep, voffB);
            PG8_WAIT_V(6); PG8_BAR; PG8_MMA(1, 1, At, B1); PG8_BAR;
            }
        }
        if constexpr (ALIGN_EPI) { if (wr == 0) PG8_BAR; }
        if constexpr (!Epi::AFTER_DRAIN) { E(acc, cur, wr, wc, fr, fq); S.done(cur); }
        if (!has_next) break;
#pragma unroll
        for (int a = 0; a < 2; ++a)
#pragma unroll
            for (int b = 0; b < 2; ++b)
#pragma unroll
                for (int m = 0; m < 4; ++m)
#pragma unroll
                    for (int n = 0; n < 2; ++n) acc[a][b][m][n] = (f32x4){0.f, 0.f, 0.f, 0.f};
        cur = nxt; cA = nA; cB = nB; ++ui;
        if constexpr (ALIGN_EPI) { if (wr == 1) PG8_BAR; }
    }
    PG8_WAIT_V(0);
    if constexpr (!ALIGN_EPI) { if (wr == 0) PG8_BAR; }
    PG8_BAR;
    if constexpr (Epi::AFTER_DRAIN) { E.fused(acc, cur, wr, wc, fr, fq, lds, wid, lane); S.done(cur); }
#undef PG8_SA
#undef PG8_SB
#undef PG8_STAGE
#undef PG8_LDA
#undef PG8_LDB
#undef PG8_MMA
#undef PG8_WAIT_V
#undef PG8_WAIT_L
#undef PG8_BAR
#undef PG8_SCHED
}
}
namespace pg8 {
struct EpiF32 {
    static constexpr bool PERM = false, AFTER_DRAIN = false;
    float* C; int ldc;
    __device__ __forceinline__ void operator()(const f32x4 (&acc)[2][2][4][2], const Unit& u, int wr, int wc, int fr, int fq) const {
        const int row0 = u.pm * BM + wr * 64 + fr, col0 = u.pn * BM + wc * 32 + 4 * fq;
#pragma unroll
        for (int ai = 0; ai < 2; ++ai)
#pragma unroll
            for (int m = 0; m < 4; ++m) { float* rowp = C + (size_t)(row0 + ai * HALF + m * 16) * ldc + col0;
#pragma unroll
                for (int bj = 0; bj < 2; ++bj)
#pragma unroll
                    for (int n = 0; n < 2; ++n) *(f32x4*)(rowp + bj * HALF + n * 16) = acc[ai][bj][m][n]; }
    }
};
__device__ __forceinline__ float sigmoid_f(float v) { return __builtin_amdgcn_rcpf(1.0f + __builtin_amdgcn_exp2f(-1.4426950408889634f * v)); }
struct EpiSwiGLU {
    static constexpr bool PERM = true, AFTER_DRAIN = false;
    bf16_t* Hh; int ldh;
    __device__ __forceinline__ void operator()(const f32x4 (&acc)[2][2][4][2], const Unit& u, int wr, int wc, int fr, int fq) const {
        const int row0 = u.pm * BM + wr * 64 + fr, col0 = u.pn * HALF + wc * 32 + 8 * fq;
#pragma unroll
        for (int ai = 0; ai < 2; ++ai)
#pragma unroll
            for (int m = 0; m < 4; ++m) { bf16_t* rowp = Hh + (size_t)(row0 + ai * HALF + m * 16) * ldh + col0;
                float h[8];
#pragma unroll
                for (int n = 0; n < 2; ++n)
#pragma unroll
                    for (int e = 0; e < 4; ++e) { const float g = acc[ai][0][m][n][e], up = acc[ai][1][m][n][e]; h[4 * n + e] = g * sigmoid_f(g) * up; }
                u32x4 w; w.x = cvt_pk_bf16(h[0], h[1]); w.y = cvt_pk_bf16(h[2], h[3]); w.z = cvt_pk_bf16(h[4], h[5]); w.w = cvt_pk_bf16(h[6], h[7]);
                *(u32x4*)rowp = w; }
    }
};
__device__ __forceinline__ float bf_lo(unsigned w) { return __builtin_bit_cast(float, w << 16); }
__device__ __forceinline__ float bf_hi(unsigned w) { return __builtin_bit_cast(float, w & 0xffff0000u); }
struct EpiGlu {
    static constexpr bool PERM = true, AFTER_DRAIN = false;
    const bf16_t* Y; bf16_t* Z; int ldc;
    __device__ __forceinline__ void operator()(const f32x4 (&acc)[2][2][4][2], const Unit& u, int wr, int wc, int fr, int fq) const {
        const int row0 = u.pm * BM + wr * 64 + fr, col0 = u.pn * BM + wc * 32 + 8 * fq;
#pragma unroll
        for (int ai = 0; ai < 2; ++ai)
#pragma unroll
            for (int m = 0; m < 4; ++m) { const size_t off = (size_t)(row0 + ai * HALF + m * 16) * ldc + col0;
#pragma unroll
                for (int bj = 0; bj < 2; ++bj) { const u32x4 y = *(const u32x4*)(Y + off + bj * HALF); const f32x4 a0 = acc[ai][bj][m][0], a1 = acc[ai][bj][m][1];
                    u32x4 w;
                    w.x = cvt_pk_bf16(bf_lo(y.x) * sigmoid_f(a0[0]), bf_hi(y.x) * sigmoid_f(a0[1]));
                    w.y = cvt_pk_bf16(bf_lo(y.y) * sigmoid_f(a0[2]), bf_hi(y.y) * sigmoid_f(a0[3]));
                    w.z = cvt_pk_bf16(bf_lo(y.z) * sigmoid_f(a1[0]), bf_hi(y.z) * sigmoid_f(a1[1]));
                    w.w = cvt_pk_bf16(bf_lo(y.w) * sigmoid_f(a1[2]), bf_hi(y.w) * sigmoid_f(a1[3]));
                    *(u32x4*)(Z + off + bj * HALF) = w; } }
    }
};
}
#include <hip/hip_bf16.h>
#include <cmath>
namespace attn_body {
using bf16=__hip_bfloat16;
using bf16x8=__attribute__((ext_vector_type(8)))short;
using s16x4=__attribute__((ext_vector_type(4)))short;
using f32x16=__attribute__((ext_vector_type(16)))float;
using u32x4=__attribute__((ext_vector_type(4)))unsigned;
constexpr int BATCH=16,NHEAD=16,SEQ=2048,D=64,DM=NHEAD*D;
constexpr int NW=8,QBLK=32,QB=QBLK*NW,KVBLK=64,NQB=SEQ/QB;
constexpr int ATTN_PITCH=DM, ATTN_UNIT_ROWS=QB;
__device__ __forceinline__ int crow(int r,int hi){return (r&3)+8*(r>>2)+4*hi;}
#define SBAR() __builtin_amdgcn_sched_barrier(0)
__device__ __forceinline__ void cmask(f32x16&p0,f32x16&p1,int jb,int qrel,int hi){
  const float NEG=-INFINITY; int kb=64*jb+4*hi;
  #pragma unroll
  for(int r=0;r<16;++r){int kv=kb+(r&3)+8*(r>>2); if(kv>qrel)p0[r]=NEG; if(kv+32>qrel)p1[r]=NEG;}
}

constexpr int NSLOT=3, SLOTB=8192;
constexpr int LDS_K=0, LDS_V=NSLOT*SLOTB, LDS_WS=2*NSLOT*SLOTB, LDS_OST=LDS_WS+NW*64*4, LDS_BT=86016, LDS_BZERO=LDS_BT+SEQ*16, LDS_BYTES=LDS_BZERO+16;
constexpr float C2=0.125f*1.4426950408889634f;
__device__ __forceinline__ void glds16(const void*gsrc,unsigned lds_dst){unsigned keep;
  asm volatile("s_mov_b32 %0, m0\n\ts_mov_b32 m0, %2\n\ts_nop 0\n\tglobal_load_lds_dwordx4 %1, off\n\ts_mov_b32 m0, %0":"=&s"(keep):"v"(gsrc),"s"(lds_dst):"memory");}
__device__ __forceinline__ float max3f(float a,float b,float c){float r;asm("v_max3_f32 %0, %1, %2, %3":"=v"(r):"v"(a),"v"(b),"v"(c));return r;}
__device__ __forceinline__ float max2f(float a,float b){float r;asm("v_max_f32_e32 %0, %1, %2":"=v"(r):"v"(a),"v"(b));return r;}
__device__ __forceinline__ float fadd_s(float a,float b){float r;asm("v_add_f32_e32 %0, %1, %2":"=v"(r):"v"(a),"v"(b));return r;}
__device__ __forceinline__ float fsub_s(float a,float b){float r;asm("v_sub_f32_e32 %0, %1, %2":"=v"(r):"v"(a),"v"(b));return r;}
typedef float f32x2_t __attribute__((ext_vector_type(2))); typedef __bf16 bf16x2_t __attribute__((ext_vector_type(2)));
__device__ __forceinline__ unsigned cvtpk_s(float lo,float hi){f32x2_t v={lo,hi};bf16x2_t b=__builtin_convertvector(v,bf16x2_t);return __builtin_bit_cast(unsigned,b);}
#define WAIT_BAR(N) asm volatile("s_waitcnt vmcnt(" #N ") lgkmcnt(0)\n\ts_barrier":::"memory")

__device__ __forceinline__ void qkt(f32x16&p0,f32x16&p1,const char*Kslot,const bf16x8*qr,int r32,int hi){
  const char*kb=Kslot+hi*1024+r32*16;
  #pragma unroll
  for(int d0=0;d0<4;++d0){
    const bf16x8 b0=*reinterpret_cast<const bf16x8*>(kb+d0*2048);
    const bf16x8 b1=*reinterpret_cast<const bf16x8*>(kb+d0*2048+512);
    if(d0==0){p0=__builtin_amdgcn_mfma_f32_32x32x16_bf16(b0,qr[0],f32x16{},0,0,0);p1=__builtin_amdgcn_mfma_f32_32x32x16_bf16(b1,qr[0],f32x16{},0,0,0);}
    else{p0=__builtin_amdgcn_mfma_f32_32x32x16_bf16(b0,qr[d0],p0,0,0,0);p1=__builtin_amdgcn_mfma_f32_32x32x16_bf16(b1,qr[d0],p1,0,0,0);}}
}
typedef __attribute__((address_space(3))) const char* lds_cptr;
typedef short v4i16_t __attribute__((ext_vector_type(4)));
__device__ __forceinline__ void kload8(bf16x8*kf,lds_cptr kp){
  kf[0]=*(const __attribute__((address_space(3))) bf16x8*)(kp);      kf[1]=*(const __attribute__((address_space(3))) bf16x8*)(kp+512);
  kf[2]=*(const __attribute__((address_space(3))) bf16x8*)(kp+2048); kf[3]=*(const __attribute__((address_space(3))) bf16x8*)(kp+2560);
  kf[4]=*(const __attribute__((address_space(3))) bf16x8*)(kp+4096); kf[5]=*(const __attribute__((address_space(3))) bf16x8*)(kp+4608);
  kf[6]=*(const __attribute__((address_space(3))) bf16x8*)(kp+6144); kf[7]=*(const __attribute__((address_space(3))) bf16x8*)(kp+6656);
}
__device__ __forceinline__ void kload2(bf16x8*kf,lds_cptr kp,int j){ kf[2*j]=*(const __attribute__((address_space(3))) bf16x8*)(kp+j*2048); kf[2*j+1]=*(const __attribute__((address_space(3))) bf16x8*)(kp+j*2048+512); }
__device__ __forceinline__ s16x4 vtr(lds_cptr p){ return __builtin_bit_cast(s16x4,__builtin_amdgcn_ds_read_tr16_b64_v4i16((__attribute__((address_space(3))) v4i16_t*)p)); }
__device__ __forceinline__ float rowmax(const f32x16&p0,const f32x16&p1){
  float a=max3f(p0[0],p0[1],p1[0]),b=max3f(p0[2],p0[3],p1[1]);a=max3f(a,p1[2],p1[3]);
  #pragma unroll
  for(int r=4;r<16;r+=4){a=max3f(a,p0[r],p0[r+1]);b=max3f(b,p0[r+2],p0[r+3]);a=max3f(a,p1[r],p1[r+1]);b=max3f(b,p1[r+2],p1[r+3]);}
  const float m=max2f(a,b);
  auto rr=__builtin_amdgcn_permlane32_swap(__float_as_uint(m),__float_as_uint(m),false,false);
  return max2f(__uint_as_float(rr[0]),__uint_as_float(rr[1]));
}
__device__ __forceinline__ void pv(f32x16*o,int vb,bf16x8 pa0,bf16x8 pa1,bf16x8 pa2,bf16x8 pa3){
  #pragma unroll
  for(int d0=0;d0<2;++d0){s16x4 lo[4],hi[4];
    #pragma unroll
    for(int ks=0;ks<4;++ks){
      asm volatile("ds_read_b64_tr_b16 %0,%1 offset:%c2":"=&v"(lo[ks]):"v"(vb),"i"(d0*4096+ks*1024):"memory");
      asm volatile("ds_read_b64_tr_b16 %0,%1 offset:%c2":"=&v"(hi[ks]):"v"(vb),"i"(d0*4096+ks*1024+512):"memory");}
    asm volatile("s_waitcnt lgkmcnt(0)":::"memory");SBAR();
    #define PK(k) (bf16x8){lo[k][0],lo[k][1],lo[k][2],lo[k][3],hi[k][0],hi[k][1],hi[k][2],hi[k][3]}
    o[d0]=__builtin_amdgcn_mfma_f32_32x32x16_bf16(pa0,PK(0),o[d0],0,0,0);
    o[d0]=__builtin_amdgcn_mfma_f32_32x32x16_bf16(pa1,PK(1),o[d0],0,0,0);
    o[d0]=__builtin_amdgcn_mfma_f32_32x32x16_bf16(pa2,PK(2),o[d0],0,0,0);
    o[d0]=__builtin_amdgcn_mfma_f32_32x32x16_bf16(pa3,PK(3),o[d0],0,0,0);
    #undef PK
  }
}

__device__ __forceinline__ float sgm(float v){ return __builtin_amdgcn_rcpf(1.0f+__builtin_amdgcn_exp2f(-1.4426950408889634f*v)); }
#ifndef ATTN_STORE16
#define ATTN_STORE16(p,v) (*(u32x4*)(p)=(v))
#endif
template<int THRL> __device__ __forceinline__ void attn_unit(int b,int h,int qb,const bf16*Q,const bf16*__restrict__ K,const bf16*__restrict__ V,bf16*O,const bf16*__restrict__ Gt,char*shm){
  int tid=threadIdx.x; asm volatile("":"+v"(tid));
  const int lane=tid&63,r32=lane&31,hi=lane>>5; const int wid=__builtin_amdgcn_readfirstlane(tid>>6);
  const long rowbase=(long)b*SEQ; const int q0=qb*QB;
  const bf16*Qw=Q+(rowbase+q0+wid*QBLK)*DM+h*D;
  const bf16*Kh=K+rowbase*DM+h*D,*Vh=V+rowbase*DM+h*D;
  const unsigned lds0=(unsigned)(uintptr_t)shm;
  float*wsf=(float*)(shm+LDS_WS)+wid*64;
  const bf16*ksrc=Kh+(long)lane*DM+wid*8;
  const bf16*vsrc=Vh+(long)(16*(wid&3)+(lane>>2))*DM+(wid>>2)*32+(lane&3)*8;
  const unsigned kdst=lds0+LDS_K+wid*1024, vdst=lds0+LDS_V+wid*1024;
  #define DMA_K(t,slot) glds16(ksrc+(long)(t)*KVBLK*DM,(unsigned)__builtin_amdgcn_readfirstlane(kdst+(slot)))
  #define DMA_V(t,slot) glds16(vsrc+(long)(t)*KVBLK*DM,(unsigned)__builtin_amdgcn_readfirstlane(vdst+(slot)))
  const int vb0=(int)(lds0+LDS_V)+((lane>>4)&1)*32+(lane&3)*8+(4*hi+((lane&15)>>2))*64;
  const char*Kbase=shm+LDS_K; bf16x8 kf[8];
  const lds_cptr shm3=(lds_cptr)shm; const lds_cptr kp0=shm3+LDS_K+hi*1024+r32*16; const lds_cptr vp0=shm3+LDS_V+((lane>>4)&1)*32+(lane&3)*8+(4*hi+((lane&15)>>2))*64;
  const lds_cptr bt0=shm3+(hi?LDS_BZERO:(LDS_BT+r32*16)); const int bstr=hi?0:1024, bof2=hi?0:512;
  #define BFR(p) (*(const __attribute__((address_space(3))) bf16x8*)(p))
  const int NT=(q0+QB)/KVBLK;
  DMA_K(0,0);DMA_V(0,0);DMA_K(1,SLOTB);
  bf16x8 qr[4];
  #pragma unroll
  for(int d0=0;d0<4;++d0)qr[d0]=*reinterpret_cast<const bf16x8*>(&Qw[(long)r32*DM+d0*16+hi*8]);
  float mhat=0.f,l_reg=0.f;f32x16 o[2];o[0]=f32x16{};o[1]=f32x16{};
  u32x4 mfw=(u32x4){0x3F803F80u,0x00003F80u,0u,0u};
  #define SETM() do{ const float v_=-mhat; const unsigned h_=cvtpk_s(v_,0.f)&0xffffu; const float r1_=v_-__uint_as_float(h_<<16); const unsigned m_=cvtpk_s(r1_,0.f)&0xffffu; const float r2_=r1_-__uint_as_float(m_<<16); \
      const unsigned l_=cvtpk_s(r2_,0.f)&0xffffu; mfw.y=0x3F80u|(h_<<16); mfw.z=m_|(l_<<16); }while(0)
  #define MFR __builtin_bit_cast(bf16x8,mfw)
  const int qrel=wid*QBLK+r32;
  #define CMASK(P0,P1,t) do{int jb_=(t)-(NT-4); if(jb_>=0)cmask(P0,P1,jb_,qrel,hi);}while(0)
  bool resc=false;
  #define START(P0,P1) do{ const float rm=rowmax(P0,P1); resc=false; \
    { const float dl=rm; mhat=fadd_s(mhat,dl); \
      _Pragma("unroll") for(int r=0;r<16;++r){P0[r]=fsub_s(P0[r],dl);P1[r]=fsub_s(P1[r],dl);} \
      SETM(); } \
    _Pragma("unroll") for(int r=0;r<16;++r)P0[r]=__builtin_amdgcn_exp2f(P0[r]); }while(0)
  #define RESC() do{ if(resc){ asm volatile("s_waitcnt lgkmcnt(0)":::"memory"); \
      _Pragma("unroll") for(int d_=0;d_<2;++d_) _Pragma("unroll") for(int r=0;r<16;++r)o[d_][r]*=wsf[crow(r,hi)]; } }while(0)
  f32x16 pA0,pA1,pB0,pB1;
  int sl_prev=0,sl_cur=0,sl_next=SLOTB;
  #define ROT() do{sl_prev=sl_cur;sl_cur=sl_next;sl_next=(sl_next==(NSLOT-1)*SLOTB)?0:sl_next+SLOTB;}while(0)
  DMA_K(2,2*SLOTB);
  WAIT_BAR(3);
  qkt(pA0,pA1,Kbase,qr,r32,hi);
  { const bf16x8 ba_=BFR(bt0), bb_=BFR(bt0+bof2); pA0=__builtin_amdgcn_mfma_f32_32x32x16_bf16(ba_,MFR,pA0,0,0,0); pA1=__builtin_amdgcn_mfma_f32_32x32x16_bf16(bb_,MFR,pA1,0,0,0); }
  asm volatile("s_nop 15\n\ts_nop 7":"+v"(pA0),"+v"(pA1));CMASK(pA0,pA1,0);
  START(pA0,pA1);
  _Pragma("unroll") for(int r=0;r<16;++r)pA1[r]=__builtin_amdgcn_exp2f(pA1[r]);
  WAIT_BAR(0);
  DMA_K(3,0);DMA_V(1,SLOTB);
  ROT();
  kload8(kf,kp0+sl_cur);
  WAIT_BAR(2);
  s16x4 vlo[8],vhi[8]; u32x4 pw0,pw1,pw2,pw3;
  #define PKW(P,B) cvtpk_s(P[B],P[B+1])
  #define PAF(k) __builtin_bit_cast(bf16x8,pw##k)
  #define VFR(i) (bf16x8){vlo[i][0],vlo[i][1],vlo[i][2],vlo[i][3],vhi[i][0],vhi[i][1],vhi[i][2],vhi[i][3]}
  #define PIN(x) asm volatile("":"+v"(x))
  #define MX3(a,b,c) __builtin_fmaxf(__builtin_fmaxf((a),(b)),(c))
  #define GAPA(MF,A0,A1,A2,A3,W0,W1,PW) do{ MF; sacc+=A0; sacc+=A1; sacc+=A2; sacc+=A3; PIN(sacc); W0; W1; PIN(PW); SBAR(); }while(0)
  #define EX(v) __builtin_amdgcn_exp2f(v)
  #define GAPB(MF,X,B) do{ MF; X[B]=EX(X[B]); X[B+1]=EX(X[B+1]); X[B+2]=EX(X[B+2]); X[B+3]=EX(X[B+3]); PIN(X); SBAR(); }while(0)
  #define VRD(i) do{ vlo[i]=vtr(vp_+(((i)>>2)*4096+((i)&3)*1024)); vhi[i]=vtr(vp_+(((i)>>2)*4096+((i)&3)*1024+512)); }while(0)
  #define KRD(G,j) do{ if(G){ kload2(kf,kp0+sl_next,j); SBAR(); } }while(0)
  #define STEP(C0,C1,P0,P1,t,GK,GV,GL) do{ SBAR(); \
    const lds_cptr vp_=vp0+sl_prev; \
    VRD(0); SBAR(); float sacc=(P0[0]+P0[1]); \
    GAPA(C0=__builtin_amdgcn_mfma_f32_32x32x16_bf16(kf[0],qr[0],f32x16{},0,0,0), P0[2],P0[3],P0[4],P0[5],     pw0[0]=PKW(P0,0), pw0[1]=PKW(P0,2), pw0); \
    VRD(4); SBAR(); GAPA(C1=__builtin_amdgcn_mfma_f32_32x32x16_bf16(kf[1],qr[0],f32x16{},0,0,0), P0[6],P0[7],P0[8],P0[9],     pw0[2]=PKW(P0,4), pw0[3]=PKW(P0,6), pw0); \
    VRD(1); SBAR(); GAPA(C0=__builtin_amdgcn_mfma_f32_32x32x16_bf16(kf[2],qr[1],C0,0,0,0),   P0[10],P0[11],P0[12],P0[13], pw1[0]=PKW(P0,8), pw1[1]=PKW(P0,10), pw1); \
    VRD(5); SBAR(); GAPA(C1=__builtin_amdgcn_mfma_f32_32x32x16_bf16(kf[3],qr[1],C1,0,0,0),   P0[14],P0[15],P1[0],P1[1],   pw1[2]=PKW(P0,12),pw1[3]=PKW(P0,14), pw1); \
    const lds_cptr bp_=bt0+(t)*bstr; const bf16x8 bfa_=BFR(bp_), bfb_=BFR(bp_+bof2); SBAR(); \
    VRD(2); SBAR(); GAPA(C0=__builtin_amdgcn_mfma_f32_32x32x16_bf16(kf[4],qr[2],C0,0,0,0),   P1[2],P1[3],P1[4],P1[5],     pw2[0]=PKW(P1,0), pw2[1]=PKW(P1,2), pw2); \
    VRD(6); SBAR(); GAPA(C1=__builtin_amdgcn_mfma_f32_32x32x16_bf16(kf[5],qr[2],C1,0,0,0),   P1[6],P1[7],P1[8],P1[9],     pw2[2]=PKW(P1,4), pw2[3]=PKW(P1,6), pw2); \
    VRD(3); SBAR(); GAPA(C0=__builtin_amdgcn_mfma_f32_32x32x16_bf16(kf[6],qr[3],C0,0,0,0),   P1[10],P1[11],P1[12],P1[13], pw3[0]=PKW(P1,8), pw3[1]=PKW(P1,10), pw3); \
    VRD(7); SBAR(); GAPA(C1=__builtin_amdgcn_mfma_f32_32x32x16_bf16(kf[7],qr[3],C1,0,0,0),   P1[14],P1[15],0.f,0.f,       pw3[2]=PKW(P1,12),pw3[3]=PKW(P1,14), pw3); \
    l_reg+=sacc; \
    C0=__builtin_amdgcn_mfma_f32_32x32x16_bf16(bfa_,MFR,C0,0,0,0); SBAR(); C1=__builtin_amdgcn_mfma_f32_32x32x16_bf16(bfb_,MFR,C1,0,0,0); SBAR(); \
    if(GK){DMA_K((t)+3,sl_cur);} if(GV){DMA_V((t)+1,sl_next);} \
    CMASK(C0,C1,t); \
    { float a=MX3(C0[0],C0[1],C1[0]),b=MX3(C0[2],C0[3],C1[1]); a=MX3(a,C1[2],C1[3]); \
      _Pragma("unroll") for(int r=4;r<16;r+=4){a=MX3(a,C0[r],C0[r+1]);b=MX3(b,C0[r+2],C0[r+3]);a=MX3(a,C1[r],C1[r+1]);b=MX3(b,C1[r+2],C1[r+3]);} \
      float rm=__builtin_fmaxf(a,b); { auto rr=__builtin_amdgcn_permlane32_swap(__float_as_uint(rm),__float_as_uint(rm),false,false); rm=__builtin_fmaxf(__uint_as_float(rr[0]),__uint_as_float(rr[1])); } \
      resc=false; \
      if(__builtin_expect(__any(rm>(float)THRL),0)){ const float dl=__builtin_fmaxf(rm,0.f); mhat+=dl; \
        _Pragma("unroll") for(int r=0;r<16;++r){C0[r]-=dl;C1[r]-=dl;} \
        SETM(); \
        const float f=__builtin_amdgcn_exp2f(-dl); l_reg*=f; if(hi==0)wsf[r32]=f; resc=true; } } \
    SBAR(); \
    GAPB(o[0]=__builtin_amdgcn_mfma_f32_32x32x16_bf16(PAF(0),VFR(0),o[0],0,0,0), C0,0); \
    GAPB(o[1]=__builtin_amdgcn_mfma_f32_32x32x16_bf16(PAF(0),VFR(4),o[1],0,0,0), C0,4); \
    KRD(GL,0); GAPB(o[0]=__builtin_amdgcn_mfma_f32_32x32x16_bf16(PAF(1),VFR(1),o[0],0,0,0), C0,8); \
    KRD(GL,1); GAPB(o[1]=__builtin_amdgcn_mfma_f32_32x32x16_bf16(PAF(1),VFR(5),o[1],0,0,0), C0,12); \
    KRD(GL,2); GAPB(o[0]=__builtin_amdgcn_mfma_f32_32x32x16_bf16(PAF(2),VFR(2),o[0],0,0,0), C1,0); \
    KRD(GL,3); GAPB(o[1]=__builtin_amdgcn_mfma_f32_32x32x16_bf16(PAF(2),VFR(6),o[1],0,0,0), C1,4); \
    GAPB(o[0]=__builtin_amdgcn_mfma_f32_32x32x16_bf16(PAF(3),VFR(3),o[0],0,0,0), C1,8); \
    GAPB(o[1]=__builtin_amdgcn_mfma_f32_32x32x16_bf16(PAF(3),VFR(7),o[1],0,0,0), C1,12); \
    }while(0)
  int t=1;
  #undef CMASK
  #define CMASK(P0,P1,t) do{}while(0)
  for(;t+5<NT;t+=2){
    STEP(pB0,pB1,pA0,pA1,t,true,true,true);     WAIT_BAR(2); RESC(); ROT();
    STEP(pA0,pA1,pB0,pB1,t+1,true,true,true);   WAIT_BAR(2); RESC(); ROT();
  }
  #undef CMASK
  #define CMASK(P0,P1,t) do{int jb_=(t)-(NT-4); if(jb_>=0)cmask(P0,P1,jb_,qrel,hi);}while(0)
  #define ENDW(tt) do{ if((tt)+3<NT){WAIT_BAR(2);} else if((tt)+2<NT){WAIT_BAR(1);} else {WAIT_BAR(0);} }while(0)
  for(;t+1<NT;t+=2){
    STEP(pB0,pB1,pA0,pA1,t,(t+3<NT),(t+1<NT),(t+1<NT));       ENDW(t);   RESC(); ROT();
    STEP(pA0,pA1,pB0,pB1,t+1,(t+4<NT),(t+2<NT),(t+2<NT));     ENDW(t+1); RESC(); ROT();
  }
  STEP(pB0,pB1,pA0,pA1,NT-1,false,false,false); RESC();
  { float sacc=pB0[0]+pB0[1]; _Pragma("unroll") for(int r=2;r<16;++r)sacc+=pB0[r]; _Pragma("unroll") for(int r=0;r<16;++r)sacc+=pB1[r]; l_reg+=sacc;
    pw0=(u32x4){PKW(pB0,0),PKW(pB0,2),PKW(pB0,4),PKW(pB0,6)};pw1=(u32x4){PKW(pB0,8),PKW(pB0,10),PKW(pB0,12),PKW(pB0,14)};pw2=(u32x4){PKW(pB1,0),PKW(pB1,2),PKW(pB1,4),PKW(pB1,6)};pw3=(u32x4){PKW(pB1,8),PKW(pB1,10),PKW(pB1,12),PKW(pB1,14)};
    SBAR(); pv(o,vb0+sl_cur,PAF(0),PAF(1),PAF(2),PAF(3)); }
  #undef PKW
  #undef PAF
  #undef VFR
  #undef PIN
  #undef MX3
  #undef GAPA
  #undef GAPB
  #undef EX
  #undef VRD
  #undef KRD
  #undef STEP
  #undef ENDW
  {auto rr=__builtin_amdgcn_permlane32_swap(__float_as_uint(l_reg),__float_as_uint(l_reg),false,false);l_reg=__uint_as_float(rr[0])+__uint_as_float(rr[1]);}
  if(hi==0)wsf[32+r32]=l_reg;asm volatile("s_waitcnt lgkmcnt(0)":::"memory");
  float rli[16];
  #pragma unroll
  for(int r=0;r<16;++r)rli[r]=__builtin_amdgcn_rcpf(wsf[32+crow(r,hi)]);
  bf16*Ow=O+(rowbase+q0+wid*QBLK)*DM+h*D; const bf16*Gw=Gt+(rowbase+q0+wid*QBLK)*DM+h*D;
  u32x4 gt[4];
  #pragma unroll
  for(int i=0;i<4;++i){const int row=i*8+(lane>>3),ch=lane&7; gt[i]=*(const u32x4*)(Gw+(long)row*DM+ch*8);}
  { bf16*stg=(bf16*)(shm+LDS_OST)+wid*2048;
    #pragma unroll
    for(int r=0;r<16;++r){const int orow=crow(r,hi);
      #pragma unroll
      for(int d0=0;d0<2;++d0)stg[orow*64+d0*32+r32]=__float2bfloat16(o[d0][r]*rli[r]);}
    asm volatile("s_waitcnt lgkmcnt(0)":::"memory");
    #pragma unroll
    for(int i=0;i<4;++i){const int row=i*8+(lane>>3),ch=lane&7; const u32x4 v=*(const u32x4*)(stg+row*64+ch*8); const u32x4 g=gt[i]; u32x4 w;
      #define GM(a,b) cvtpk_s(__uint_as_float((a)<<16)*sgm(__uint_as_float((b)<<16)), __uint_as_float((a)&0xffff0000u)*sgm(__uint_as_float((b)&0xffff0000u)))
      w.x=GM(v.x,g.x); w.y=GM(v.y,g.y); w.z=GM(v.z,g.z); w.w=GM(v.w,g.w);
      #undef GM
      ATTN_STORE16(Ow+(long)row*DM+ch*8,w);} }
  asm volatile("s_waitcnt lgkmcnt(0)\n\ts_barrier":::"memory");
  #undef BFR
  #undef SETM
  #undef MFR
  #undef DMA_K
  #undef DMA_V
  #undef CMASK
  #undef START
  #undef RESC
  #undef ROT
}
__device__ __forceinline__ void fox_bias_table(int b,int h,const float*__restrict__ LOGF,char*shm){
  int tid=threadIdx.x; asm volatile("":"+v"(tid));
  const int lane=tid&63; const int wid=__builtin_amdgcn_readfirstlane(tid>>6);
  float*wtot=(float*)(shm+LDS_WS); u32x4*BT=(u32x4*)(shm+LDS_BT);
  const int t0=4*tid; const float*lp=LOGF+((long)b*SEQ+t0)*NHEAD+h;
  const float lf0=lp[0],lf1=lp[NHEAD],lf2=lp[2*NHEAD],lf3=lp[3*NHEAD];
  const float s1=lf0+lf1,s2=s1+lf2,s3=s2+lf3; float inc=s3;
  #pragma unroll
  for(int o=1;o<64;o<<=1){const float v=__shfl_up(inc,o); if(lane>=o)inc+=v;}
  __syncthreads();
  if(lane==63)wtot[wid]=inc;
  __syncthreads();
  float woff=0.f; for(int w=0;w<wid;++w)woff+=wtot[w];
  const float ex=inc-s3+woff; const float cs[4]={ex+lf0,ex+s1,ex+s2,ex+s3};
  #pragma unroll
  for(int i=0;i<4;++i){ const float v=-cs[i]*1.4426950408889634f;
    const unsigned hb=__builtin_bit_cast(unsigned,v); const unsigned h16=(hb+0x7fffu+((hb>>16)&1u))>>16; const float r1=v-__uint_as_float(h16<<16);
    const unsigned mb=__builtin_bit_cast(unsigned,r1); const unsigned m16=(mb+0x7fffu+((mb>>16)&1u))>>16; const float r2=r1-__uint_as_float(m16<<16);
    const unsigned lb=__builtin_bit_cast(unsigned,r2); const unsigned l16=(lb+0x7fffu+((lb>>16)&1u))>>16;
    BT[t0+i]=(u32x4){h16|(m16<<16),l16|0x3F800000u,0x3F803F80u,0u}; }
  { unsigned z0=0u; asm volatile("":"+v"(z0)); if(tid==0)*(u32x4*)(shm+LDS_BZERO)=(u32x4){z0,z0,z0,z0}; }
  __syncthreads();
}
constexpr int ATTN_LDS_BYTES=LDS_BYTES;
struct AttnTensors { const bf16* Q; const bf16* K; const bf16* V; bf16* O; };
template<int THRL=8> __device__ __forceinline__ void attn_phase_fox(char*lds,const AttnTensors&T,const bf16*Gt,const float*LOGF,int vcu,int G){
  for(int bh=vcu;bh<BATCH*NHEAD;bh+=G){ const int b=bh/NHEAD,h=bh%NHEAD;
    fox_bias_table(b,h,LOGF,lds);
    for(int qb=NQB-1;qb>=0;--qb) attn_unit<THRL>(b,h,qb,T.Q,T.K,T.V,T.O,Gt,lds);
  }
}
#undef SBAR
#undef WAIT_BAR
}
#ifndef PG8_SP2
#define PG8_SP2 true
#endif
#ifndef PG8_ALIGN
#define PG8_ALIGN true
#endif
#ifndef MK_ONE_LAUNCH
#define MK_ONE_LAUNCH 1
#endif
constexpr int NWAVES = 8;
constexpr int BATCH = 16, SEQ = 2048, D = 1024, NH = 16, HD = 64, FF = 2816, M = BATCH * SEQ;
constexpr int NFOX = 4 * D + NH;
constexpr int NG = 64, NP = 64, GC = 16;
constexpr float EPS = 1e-6f;
constexpr float LOG2E = 1.4426950408889634f;
constexpr float C2 = 0.125f * LOG2E;
constexpr size_t MiB = 1u << 20;
constexpr size_t WS_CTL = 0, CTL_ZERO_BYTES = 1 * MiB;
constexpr size_t WS_WFOX = 2 * MiB;
constexpr size_t WS_WF = 10 * MiB;
constexpr size_t WS_WFO = 11 * MiB, WS_WSI = 13 * MiB, WS_WSG = 15 * MiB, WS_WSO = 17 * MiB;
constexpr size_t WS_WGU0 = 19 * MiB, WS_WD0 = 30 * MiB, WS_WGU1 = 36 * MiB, WS_WD1 = 47 * MiB;
constexpr size_t WS_LOGF = 54 * MiB;
constexpr size_t WS_XCH = 56 * MiB;
constexpr size_t WS_XN = 64 * MiB;
constexpr size_t WS_Q = 128 * MiB, WS_K = 192 * MiB, WS_V = 256 * MiB, WS_GT = 320 * MiB;
constexpr size_t WS_H = 128 * MiB;
constexpr size_t WS_U = 128 * MiB, WS_Y = 192 * MiB, WS_Z = 256 * MiB;
constexpr size_t WS_SCR = 320 * MiB;
constexpr size_t WS_END = 448 * MiB;
constexpr int CW_TMO = 0, CW_CODE = 1, CW_BAR = 4096;
constexpr int RING_OFF = 0, RING_BYTES = 131072;
constexpr int LDSCTL_OFF = RING_BYTES, MISC_OFF = LDSCTL_OFF + 320;
constexpr int LDS_BYTES = 147456;
#define GAS __attribute__((address_space(1)))
#define LAS __attribute__((address_space(3)))
typedef unsigned short bf16;
typedef unsigned v4u __attribute__((ext_vector_type(4)));
typedef float f32x4 __attribute__((ext_vector_type(4)));
typedef GAS unsigned gu32;
#define RLX_AGENT __ATOMIC_RELAXED, __HIP_MEMORY_SCOPE_AGENT
#define LDS_WAIT() asm volatile("s_waitcnt lgkmcnt(0)" ::: "memory")
#define VM_WAIT() asm volatile("s_waitcnt vmcnt(0)" ::: "memory")
__device__ __forceinline__ unsigned f2bf(float f) { unsigned u = __builtin_bit_cast(unsigned, f); return (u + 0x7fffu + ((u >> 16) & 1u)) >> 16; }
__device__ __forceinline__ unsigned pk2(float lo, float hi) { return f2bf(lo) | (f2bf(hi) << 16); }
__device__ __forceinline__ float bflo(unsigned w) { return __builtin_bit_cast(float, w << 16); }
__device__ __forceinline__ float bfhi(unsigned w) { return __builtin_bit_cast(float, w & 0xffff0000u); }
__device__ __forceinline__ float sigm(float v) { return __builtin_amdgcn_rcpf(1.0f + __builtin_amdgcn_exp2f(-LOG2E * v)); }

#define XB_TMO      128
#define XB_XCNT(j)  (256  + 64 * (j))
#define XB_XSUB(j)  (1280 + 64 * (j))
#define XB_XGEN(j)  (2304 + 64 * (j))
#define XB_TOP      3328
#define XB_TOPGEN   3392
#define XCD_BAR_WORDS 3456
#define XB_SPIN_CAP (1u << 18)
__device__ __forceinline__ unsigned xb_ld(unsigned* p)              { return __hip_atomic_load(p, __ATOMIC_RELAXED, __HIP_MEMORY_SCOPE_AGENT); }
__device__ __forceinline__ unsigned xb_add(unsigned* p, unsigned v) { return __hip_atomic_fetch_add(p, v, __ATOMIC_RELAXED, __HIP_MEMORY_SCOPE_AGENT); }
__device__ __forceinline__ unsigned xb_xcc_id() { return (unsigned)__builtin_amdgcn_s_getreg((3 << 11) | 20) & 0xFu; }
#define XB_SPIN(cond, bar) do { unsigned _sp = 0; while (cond) { __builtin_amdgcn_s_sleep(1); \
    if ((++_sp & 255u) == 0u) { if (xb_ld(&(bar)[XB_TMO])) break; if (_sp > XB_SPIN_CAP) { atomicAdd(&(bar)[XB_TMO], 1u); break; } } } } while (0)
struct XcdBarrier { unsigned* bar; unsigned x; volatile LAS unsigned* st; };
__device__ __forceinline__ XcdBarrier xcd_barrier_post(unsigned* bar, volatile LAS unsigned* st) {
    XcdBarrier b; b.bar = bar; b.x = xb_xcc_id(); b.st = st;
    if (threadIdx.x == 0) (void)xb_add(&bar[XB_XCNT(b.x)], 1u);
    return b;
}
__device__ __forceinline__ void xcd_barrier_complete(unsigned* bar, unsigned x, unsigned& nloc, unsigned& nx) {
    const unsigned G = gridDim.x * gridDim.y * gridDim.z;
    unsigned sum, cnt, mine, sp = 0u;
    for (;;) {
        sum = 0u; cnt = 0u; mine = 0u;
#pragma unroll
        for (unsigned j = 0; j < 16; ++j) { const unsigned c = xb_ld(&bar[XB_XCNT(j)]); sum += c; cnt += (c > 0u) ? 1u : 0u; mine = (j == x) ? c : mine; }
        if (sum == G) break;
        __builtin_amdgcn_s_sleep(1);
        if ((++sp & 255u) == 0u) { if (xb_ld(&bar[XB_TMO])) break; if (sp > XB_SPIN_CAP) { atomicAdd(&bar[XB_TMO], 1u); break; } }
    }
    nloc = mine > 0u ? mine : 1u; nx = cnt > 0u ? cnt : 1u;
}
__device__ __forceinline__ void xcd_barrier(const XcdBarrier& b) {
    asm volatile("s_waitcnt vmcnt(0)" ::: "memory");
    __syncthreads();
    if (threadIdx.x == 0) {
        unsigned* bar = b.bar;
        __builtin_amdgcn_s_waitcnt(0);
        unsigned nloc = b.st[0], nx = b.st[1];
        if (nloc == 0u) { xcd_barrier_complete(bar, b.x, nloc, nx); b.st[0] = nloc; b.st[1] = nx; }
        const unsigned old = xb_add(&bar[XB_XSUB(b.x)], 1u);
        const unsigned gen = old / nloc;
        if (old + 1u == (gen + 1u) * nloc) {
            __builtin_amdgcn_fence(__ATOMIC_RELEASE, "agent");
            asm volatile("s_waitcnt vmcnt(0)" ::: "memory");
            const unsigned og = xb_add(&bar[XB_TOP], 1u);
            const unsigned tg = og / nx;
            if (og + 1u == (tg + 1u) * nx) xb_add(&bar[XB_TOPGEN], 1u);
            else XB_SPIN(xb_ld(&bar[XB_TOPGEN]) == tg, bar);
            __builtin_amdgcn_fence(__ATOMIC_ACQUIRE, "agent");
            xb_add(&bar[XB_XGEN(b.x)], 1u);
            asm volatile("s_waitcnt vmcnt(0)" ::: "memory");
        } else {
            XB_SPIN(xb_ld(&bar[XB_XGEN(b.x)]) == gen, bar);
            __builtin_amdgcn_fence(__ATOMIC_ACQUIRE, "agent");
            asm volatile("s_waitcnt vmcnt(0)" ::: "memory");
        }
    }
    __syncthreads();
}

struct Args { const float* in[24]; float* out; unsigned char* ws; int ph_lo, ph_hi; };
struct Frame {
    LAS unsigned char* lds;
    volatile LAS unsigned* MISC;
    gu32* ctl;
    int tid, lane, wave, vcu, G;
    unsigned char* ws;
    float* out;
};
__device__ __forceinline__ float wave_sum(float v) {
#pragma unroll
    for (int o = 1; o < 64; o <<= 1) v += __shfl_xor(v, o);
    return v;
}
__device__ __forceinline__ void transpose_item(const float* W, int ldw, const float* gain, bf16* WT, int K, int k0, int n0, int drow0, LAS float* scr, int lane) {
#pragma unroll 8
    for (int i = 0; i < 32; ++i) { const int kk = 2 * i + (lane >> 5); const float g = gain ? gain[k0 + kk] : 1.f; scr[kk * 33 + (lane & 31)] = W[(size_t)(k0 + kk) * ldw + n0 + (lane & 31)] * g; }
    LDS_WAIT(); asm volatile("" ::: "memory");
    const int c = lane & 7;
#pragma unroll
    for (int j = 0; j < 4; ++j) { const int n = (lane >> 3) + 8 * j; const LAS float* s = scr + (8 * c) * 33 + n;
        v4u o; o.x = pk2(s[0 * 33], s[1 * 33]); o.y = pk2(s[2 * 33], s[3 * 33]); o.z = pk2(s[4 * 33], s[5 * 33]); o.w = pk2(s[6 * 33], s[7 * 33]);
        *(GAS v4u*)(WT + (size_t)(drow0 + n) * K + k0 + 8 * c) = o; }
    LDS_WAIT(); asm volatile("" ::: "memory");
}
__device__ __forceinline__ void rms_row_to_bf16(const float* xrow, bf16* orow, int lane) {
    const GAS f32x4* xr = (const GAS f32x4*)xrow + lane;
    f32x4 v[4]; float s = 0.f;
#pragma unroll
    for (int j = 0; j < 4; ++j) { v[j] = xr[64 * j]; s += (v[j].x * v[j].x + v[j].y * v[j].y) + (v[j].z * v[j].z + v[j].w * v[j].w); }
    const float r = 1.0f / sqrtf(wave_sum(s) * (1.f / D) + EPS);
    GAS unsigned long long* o8 = (GAS unsigned long long*)orow + lane;
#pragma unroll
    for (int j = 0; j < 4; ++j) o8[64 * j] = (unsigned long long)pk2(v[j].x * r, v[j].y * r) | ((unsigned long long)pk2(v[j].z * r, v[j].w * r) << 32);
}
__device__ __forceinline__ void p0_prologue(Frame& F, const Args& A) {
    LAS float* scr = (LAS float*)(F.lds + RING_OFF + F.wave * 16384);
    const int gw = F.vcu * NWAVES + F.wave, NGW = F.G * NWAVES;
    constexpr int I_FOX = 16 * 128, I_SQ = 16 * 32, I_FF = 16 * 88, I_DN = 44 * 32;
    constexpr int NITEMS = I_FOX + 4 * I_SQ + 4 * I_FF + 2 * I_DN;
    unsigned char* ws = F.ws;
    for (int it = gw; it < NITEMS; it += NGW) {
        int r = it; const float* W; int ldw; const float* gain; bf16* WT; int K, N, mode;
        if (r < I_FOX) { W = A.in[1]; ldw = NFOX; gain = A.in[17]; WT = (bf16*)(ws + WS_WFOX); K = D; N = 4 * D; mode = 0; }
        else if ((r -= I_FOX) < I_SQ) { W = A.in[5]; ldw = D; gain = nullptr; WT = (bf16*)(ws + WS_WFO); K = D; N = D; mode = 0; }
        else if ((r -= I_SQ) < I_SQ) { W = A.in[6]; ldw = D; gain = A.in[17] + D; WT = (bf16*)(ws + WS_WSI); K = D; N = D; mode = 0; }
        else if ((r -= I_SQ) < I_SQ) { W = A.in[15]; ldw = D; gain = nullptr; WT = (bf16*)(ws + WS_WSG); K = D; N = D; mode = 0; }
        else if ((r -= I_SQ) < I_SQ) { W = A.in[16]; ldw = D; gain = nullptr; WT = (bf16*)(ws + WS_WSO); K = D; N = D; mode = 0; }
        else if ((r -= I_SQ) < I_FF) { W = A.in[21]; ldw = FF; gain = A.in[19]; WT = (bf16*)(ws + WS_WGU0); K = D; N = FF; mode = 1; }
        else if ((r -= I_FF) < I_FF) { W = A.in[22]; ldw = FF; gain = A.in[19]; WT = (bf16*)(ws + WS_WGU0); K = D; N = FF; mode = 2; }
        else if ((r -= I_FF) < I_DN) { W = A.in[23]; ldw = D; gain = nullptr; WT = (bf16*)(ws + WS_WD0); K = FF; N = D; mode = 0; }
        else if ((r -= I_DN) < I_FF) { W = A.in[21] + (size_t)D * FF; ldw = FF; gain = A.in[19] + D; WT = (bf16*)(ws + WS_WGU1); K = D; N = FF; mode = 1; }
        else if ((r -= I_FF) < I_FF) { W = A.in[22] + (size_t)D * FF; ldw = FF; gain = A.in[19] + D; WT = (bf16*)(ws + WS_WGU1); K = D; N = FF; mode = 2; }
        else { r -= I_FF; W = A.in[23] + (size_t)FF * D; ldw = D; gain = nullptr; WT = (bf16*)(ws + WS_WD1); K = FF; N = D; mode = 0; }
        const int nnb = N / 32, kb = r / nnb, nb = r % nnb, k0 = 64 * kb, n0 = 32 * nb;
        const int drow0 = (mode == 0) ? n0 : (256 * (n0 / 128) + (n0 % 128) + (mode == 2 ? 128 : 0));
        transpose_item(W, ldw, gain, WT, K, k0, n0, drow0, scr, F.lane);
    }
    {
        const int gt = gw * 64 + F.lane, NT = NGW * 64; bf16* WF = (bf16*)(ws + WS_WF);
        for (int e = gt; e < NH * D; e += NT) { const int h = e & 15, k = e >> 4; WF[h * D + k] = (bf16)f2bf(A.in[1][(size_t)k * NFOX + 4 * D + h] * A.in[17][k]); }
    }
    bf16* XN = (bf16*)(ws + WS_XN);
    for (int m = gw; m < M; m += NGW) rms_row_to_bf16(A.in[0] + (size_t)m * D, XN + (size_t)m * D, F.lane);
}
__device__ __forceinline__ void nr_pass(Frame& F, const float* acc, const float* xin, const float* gain, float* xout, bf16* xn) {
    const int gw = F.vcu * NWAVES + F.wave, NGW = F.G * NWAVES;
    for (int m = gw; m < M; m += NGW) {
        const GAS f32x4* ar = (const GAS f32x4*)(acc + (size_t)m * D) + F.lane; const GAS f32x4* xr = (const GAS f32x4*)(xin + (size_t)m * D) + F.lane;
        const GAS f32x4* gr = (const GAS f32x4*)gain + F.lane; GAS f32x4* orow = (GAS f32x4*)(xout + (size_t)m * D) + F.lane;
        f32x4 a[4], x[4]; float s = 0.f;
#pragma unroll
        for (int j = 0; j < 4; ++j) { a[j] = ar[64 * j]; x[j] = xr[64 * j]; s += (a[j].x * a[j].x + a[j].y * a[j].y) + (a[j].z * a[j].z + a[j].w * a[j].w); }
        const float r = 1.0f / sqrtf(wave_sum(s) * (1.f / D) + EPS); float s2 = 0.f;
#pragma unroll
        for (int j = 0; j < 4; ++j) { x[j] = x[j] + a[j] * r * gr[64 * j]; orow[64 * j] = x[j]; s2 += (x[j].x * x[j].x + x[j].y * x[j].y) + (x[j].z * x[j].z + x[j].w * x[j].w); }
        if (xn) { const float r2 = 1.0f / sqrtf(wave_sum(s2) * (1.f / D) + EPS);
            GAS unsigned long long* o8 = (GAS unsigned long long*)(xn + (size_t)m * D) + F.lane;
#pragma unroll
            for (int j = 0; j < 4; ++j) o8[64 * j] = (unsigned long long)pk2(x[j].x * r2, x[j].y * r2) | ((unsigned long long)pk2(x[j].z * r2, x[j].w * r2) << 32); }
    }
}
__device__ __forceinline__ float log_sigmoid_f(float z) {
    const float e = __expf(-fabsf(z));
    const float l1p = (e < 0.01f) ? e * (1.f - e * (0.5f - e * 0.33333333f)) : __logf(1.f + e);
    return fminf(z, 0.f) - l1p;
}
__device__ __forceinline__ void flog_naive(Frame& F, const float* b_f) {
    const int gw = F.vcu * NWAVES + F.wave, NGW = F.G * NWAVES;
    const bf16* XN = (const bf16*)(F.ws + WS_XN); const bf16* WF = (const bf16*)(F.ws + WS_WF); float* LOGF = (float*)(F.ws + WS_LOGF);
    for (int m = gw; m < M; m += NGW) {
        const GAS v4u* xr = (const GAS v4u*)(XN + (size_t)m * D) + 2 * F.lane; const v4u x0 = xr[0], x1 = xr[1];
        float xv[16];
        xv[0] = bflo(x0.x); xv[1] = bfhi(x0.x); xv[2] = bflo(x0.y); xv[3] = bfhi(x0.y); xv[4] = bflo(x0.z); xv[5] = bfhi(x0.z); xv[6] = bflo(x0.w); xv[7] = bfhi(x0.w);
        xv[8] = bflo(x1.x); xv[9] = bfhi(x1.x); xv[10] = bflo(x1.y); xv[11] = bfhi(x1.y); xv[12] = bflo(x1.z); xv[13] = bfhi(x1.z); xv[14] = bflo(x1.w); xv[15] = bfhi(x1.w);
        float mine = 0.f;
#pragma unroll
        for (int h = 0; h < NH; ++h) { const GAS v4u* wr = (const GAS v4u*)(WF + (size_t)h * D) + 2 * F.lane; const v4u w0 = wr[0], w1 = wr[1];
            float p = xv[0] * bflo(w0.x) + xv[1] * bfhi(w0.x) + xv[2] * bflo(w0.y) + xv[3] * bfhi(w0.y) + xv[4] * bflo(w0.z) + xv[5] * bfhi(w0.z) + xv[6] * bflo(w0.w) + xv[7] * bfhi(w0.w)
                    + xv[8] * bflo(w1.x) + xv[9] * bfhi(w1.x) + xv[10] * bflo(w1.y) + xv[11] * bfhi(w1.y) + xv[12] * bflo(w1.z) + xv[13] * bfhi(w1.z) + xv[14] * bflo(w1.w) + xv[15] * bfhi(w1.w);
            p = wave_sum(p); if (F.lane == h) mine = p; }
        if (F.lane < NH) LOGF[(size_t)m * NH + F.lane] = log_sigmoid_f(mine + b_f[F.lane]);
    }
}
__device__ __forceinline__ void headnorm_naive(Frame& F, const float* qg, const float* kg) {
    const int gw = F.vcu * NWAVES + F.wave, NGW = F.G * NWAVES;
    for (int it = gw; it < 2 * M; it += NGW) {
        const int which = it >= M ? 1 : 0, row = it - which * M;
        bf16* base = (bf16*)(F.ws + (which ? WS_K : WS_Q)) + (size_t)row * D; const float* gn = which ? kg : qg;
        GAS v4u* p = (GAS v4u*)base + 2 * F.lane; const v4u x0 = p[0], x1 = p[1];
        float v[16];
        v[0] = bflo(x0.x); v[1] = bfhi(x0.x); v[2] = bflo(x0.y); v[3] = bfhi(x0.y); v[4] = bflo(x0.z); v[5] = bfhi(x0.z); v[6] = bflo(x0.w); v[7] = bfhi(x0.w);
        v[8] = bflo(x1.x); v[9] = bfhi(x1.x); v[10] = bflo(x1.y); v[11] = bfhi(x1.y); v[12] = bflo(x1.z); v[13] = bfhi(x1.z); v[14] = bflo(x1.w); v[15] = bfhi(x1.w);
        float s = 0.f;
#pragma unroll
        for (int i = 0; i < 16; ++i) s += v[i] * v[i];
        s += __shfl_xor(s, 1); s += __shfl_xor(s, 2);
        float r = 1.0f / sqrtf(s * (1.f / HD) + EPS); if (!which) r *= C2;
        const int d0 = 16 * (F.lane & 3);
#pragma unroll
        for (int i = 0; i < 16; ++i) v[i] = v[i] * r * gn[d0 + i];
        v4u o0, o1; o0.x = pk2(v[0], v[1]); o0.y = pk2(v[2], v[3]); o0.z = pk2(v[4], v[5]); o0.w = pk2(v[6], v[7]);
        o1.x = pk2(v[8], v[9]); o1.y = pk2(v[10], v[11]); o1.z = pk2(v[12], v[13]); o1.w = pk2(v[14], v[15]);
        p[0] = o0; p[1] = o1;
    }
}
__device__ __forceinline__ void attn_naive(Frame& F) {
    LAS float* bias2 = (LAS float*)(F.lds);
    LAS unsigned char* Kt = F.lds + 8192; LAS unsigned char* Vt = F.lds + 16384; LAS float* wtot = (LAS float*)(F.lds + 24576);
    const float* LOGF = (const float*)(F.ws + WS_LOGF);
    const bf16* Qb = (const bf16*)(F.ws + WS_Q); const bf16* Kb = (const bf16*)(F.ws + WS_K); const bf16* Vb = (const bf16*)(F.ws + WS_V); const bf16* Gb = (const bf16*)(F.ws + WS_GT);
    bf16* Ob = (bf16*)(F.ws + WS_Q);
    for (int bh = F.vcu; bh < BATCH * NH; bh += F.G) {
        const int b = bh / NH, h = bh % NH;
        __syncthreads();
        {   const int t0 = 4 * F.tid; float lf0, lf1, lf2, lf3;
            lf0 = LOGF[((size_t)b * SEQ + t0 + 0) * NH + h]; lf1 = LOGF[((size_t)b * SEQ + t0 + 1) * NH + h]; lf2 = LOGF[((size_t)b * SEQ + t0 + 2) * NH + h]; lf3 = LOGF[((size_t)b * SEQ + t0 + 3) * NH + h];
            const float s1 = lf0 + lf1, s2 = s1 + lf2, s3 = s2 + lf3; float inc = s3;
#pragma unroll
            for (int o = 1; o < 64; o <<= 1) { const float v = __shfl_up(inc, o); if (F.lane >= o) inc += v; }
            if (F.lane == 63) wtot[F.wave] = inc;
            __syncthreads();
            float woff = 0.f; for (int w = 0; w < F.wave; ++w) woff += wtot[w];
            const float ex = inc - s3 + woff;
            bias2[t0] = -(ex + lf0) * LOG2E; bias2[t0 + 1] = -(ex + s1) * LOG2E; bias2[t0 + 2] = -(ex + s2) * LOG2E; bias2[t0 + 3] = -(ex + s3) * LOG2E;
        }
        __syncthreads();
        for (int qblk = 0; qblk < 4; ++qblk) {
            const int q = 512 * qblk + F.tid; const size_t R = (size_t)b * SEQ + q;
            float qv[64], o[64];
#pragma unroll
            for (int ch = 0; ch < 8; ++ch) { const v4u w = *(const GAS v4u*)(Qb + R * D + h * HD + 8 * ch);
                qv[8 * ch] = bflo(w.x); qv[8 * ch + 1] = bfhi(w.x); qv[8 * ch + 2] = bflo(w.y); qv[8 * ch + 3] = bfhi(w.y); qv[8 * ch + 4] = bflo(w.z); qv[8 * ch + 5] = bfhi(w.z); qv[8 * ch + 6] = bflo(w.w); qv[8 * ch + 7] = bfhi(w.w); }
#pragma unroll
            for (int d = 0; d < 64; ++d) o[d] = 0.f;
            float mx = -INFINITY, l = 0.f;
            const int ntile = 8 * (qblk + 1);
            for (int jt = 0; jt < ntile; ++jt) {
                __syncthreads();
                {   const int j = F.tid >> 3, ch = F.tid & 7; const size_t src = ((size_t)b * SEQ + 64 * jt + j) * D + h * HD + 8 * ch;
                    *(LAS v4u*)(Kt + j * 128 + ch * 16) = *(const GAS v4u*)(Kb + src); *(LAS v4u*)(Vt + j * 128 + ch * 16) = *(const GAS v4u*)(Vb + src); }
                __syncthreads();
                for (int j = 0; j < 64; ++j) {
                    const int s = 64 * jt + j;
                    if (s <= q) {
                        float dot = 0.f;
#pragma unroll
                        for (int ch = 0; ch < 8; ++ch) { const v4u w = *(const LAS v4u*)(Kt + j * 128 + ch * 16);
                            dot += qv[8 * ch] * bflo(w.x) + qv[8 * ch + 1] * bfhi(w.x) + qv[8 * ch + 2] * bflo(w.y) + qv[8 * ch + 3] * bfhi(w.y) + qv[8 * ch + 4] * bflo(w.z) + qv[8 * ch + 5] * bfhi(w.z) + qv[8 * ch + 6] * bflo(w.w) + qv[8 * ch + 7] * bfhi(w.w); }
                        const float sv = dot + bias2[s];
                        if (sv > mx) { const float al = __builtin_amdgcn_exp2f(mx - sv); l *= al;
#pragma unroll
                            for (int d = 0; d < 64; ++d) o[d] *= al;
                            mx = sv; }
                        const float p = __builtin_amdgcn_exp2f(sv - mx); l += p;
#pragma unroll
                        for (int ch = 0; ch < 8; ++ch) { const v4u w = *(const LAS v4u*)(Vt + j * 128 + ch * 16);
                            o[8 * ch] += p * bflo(w.x); o[8 * ch + 1] += p * bfhi(w.x); o[8 * ch + 2] += p * bflo(w.y); o[8 * ch + 3] += p * bfhi(w.y); o[8 * ch + 4] += p * bflo(w.z); o[8 * ch + 5] += p * bfhi(w.z); o[8 * ch + 6] += p * bflo(w.w); o[8 * ch + 7] += p * bfhi(w.w); }
                    }
                }
            }
            const float il = 1.0f / l;
#pragma unroll
            for (int ch = 0; ch < 8; ++ch) { const v4u g = *(const GAS v4u*)(Gb + R * D + h * HD + 8 * ch); v4u w;
                w.x = pk2(o[8 * ch] * il * sigm(bflo(g.x)), o[8 * ch + 1] * il * sigm(bfhi(g.x))); w.y = pk2(o[8 * ch + 2] * il * sigm(bflo(g.y)), o[8 * ch + 3] * il * sigm(bfhi(g.y)));
                w.z = pk2(o[8 * ch + 4] * il * sigm(bflo(g.z)), o[8 * ch + 5] * il * sigm(bfhi(g.z))); w.w = pk2(o[8 * ch + 6] * il * sigm(bflo(g.w)), o[8 * ch + 7] * il * sigm(bfhi(g.w)));
                *(GAS v4u*)(Ob + R * D + h * HD + 8 * ch) = w; }
        }
    }
}
__device__ __forceinline__ float gelu_tanh(float v) { return v * sigm(1.5957691216f * (v + 0.044715f * v * v * v)); }
__device__ __forceinline__ void s5_naive(Frame& F, const Args& A) {
    const int gw = F.vcu * NWAVES + F.wave, NGW = F.G * NWAVES;
    const bf16* U = (const bf16*)(F.ws + WS_U); bf16* Y = (bf16*)(F.ws + WS_Y);
    for (int item = gw; item < BATCH * NG; item += NGW) {
        const int b = item / NG, g = item % NG, p = F.lane;
        const float dt = __expf(A.in[7][g]);
        const float lr = A.in[8][g * NP + p], li = A.in[9][g * NP + p];
        const float mag = __expf(lr * dt);
        float rev = li * dt * 0.15915494309189535f; rev -= floorf(rev);
        const float a_re = mag * __builtin_amdgcn_cosf(rev), a_im = mag * __builtin_amdgcn_sinf(rev);
        const float den = lr * lr + li * li, nre = a_re - 1.f;
        const float z_re = (nre * lr + a_im * li) / den, z_im = (a_im * lr - nre * li) / den;
        float bbr[16], bbi[16], cr[16], ci[16];
#pragma unroll
        for (int c = 0; c < GC; ++c) { const float br = A.in[10][(size_t)(g * NP + p) * GC + c], bi = A.in[11][(size_t)(g * NP + p) * GC + c];
            bbr[c] = z_re * br - z_im * bi; bbi[c] = z_re * bi + z_im * br;
            cr[c] = A.in[12][(size_t)(g * GC + c) * NP + p]; ci[c] = A.in[13][(size_t)(g * GC + c) * NP + p]; }
        const int cw = (F.lane >> 2) & 15;
        const float dsk = A.in[14][g * GC + cw];
        float xr = 0.f, xi = 0.f;
        const bf16* up = U + (size_t)b * SEQ * D + g * GC; bf16* yp = Y + (size_t)b * SEQ * D + g * GC;
        v4u u0 = *(const GAS v4u*)up, u1 = *(const GAS v4u*)(up + 8); unsigned us = up[cw];
        for (int t = 0; t < SEQ; ++t) {
            const v4u c0 = u0, c1 = u1; const unsigned cs = us;
            if (t + 1 < SEQ) { u0 = *(const GAS v4u*)(up + (size_t)(t + 1) * D); u1 = *(const GAS v4u*)(up + (size_t)(t + 1) * D + 8); us = up[(size_t)(t + 1) * D + cw]; }
            float uv[16];
            uv[0] = bflo(c0.x); uv[1] = bfhi(c0.x); uv[2] = bflo(c0.y); uv[3] = bfhi(c0.y); uv[4] = bflo(c0.z); uv[5] = bfhi(c0.z); uv[6] = bflo(c0.w); uv[7] = bfhi(c0.w);
            uv[8] = bflo(c1.x); uv[9] = bfhi(c1.x); uv[10] = bflo(c1.y); uv[11] = bfhi(c1.y); uv[12] = bflo(c1.z); uv[13] = bfhi(c1.z); uv[14] = bflo(c1.w); uv[15] = bfhi(c1.w);
            float bur = 0.f, bui = 0.f;
#pragma unroll
            for (int c = 0; c < GC; ++c) { bur += bbr[c] * uv[c]; bui += bbi[c] * uv[c]; }
            const float nxr = a_re * xr - a_im * xi + bur, nxi = a_re * xi + a_im * xr + bui; xr = nxr; xi = nxi;
            float y[16];
#pragma unroll
            for (int c = 0; c < GC; ++c) y[c] = cr[c] * xr - ci[c] * xi;
            const bool b5 = (F.lane & 32) != 0, b4 = (F.lane & 16) != 0, b3 = (F.lane & 8) != 0, b2 = (F.lane & 4) != 0;
            float w8[8], w4[4], w2[2];
#pragma unroll
            for (int i = 0; i < 8; ++i) { const float send = b5 ? y[i] : y[i + 8], keep = b5 ? y[i + 8] : y[i]; w8[i] = keep + __shfl_xor(send, 32); }
#pragma unroll
            for (int i = 0; i < 4; ++i) { const float send = b4 ? w8[i] : w8[i + 4], keep = b4 ? w8[i + 4] : w8[i]; w4[i] = keep + __shfl_xor(send, 16); }
#pragma unroll
            for (int i = 0; i < 2; ++i) { const float send = b3 ? w4[i] : w4[i + 2], keep = b3 ? w4[i + 2] : w4[i]; w2[i] = keep + __shfl_xor(send, 8); }
            float w1; { const float send = b2 ? w2[0] : w2[1], keep = b2 ? w2[1] : w2[0]; w1 = keep + __shfl_xor(send, 4); }
            w1 += __shfl_xor(w1, 2); w1 += __shfl_xor(w1, 1);
            if ((F.lane & 3) == 0) { const float v = w1 + dsk * __builtin_bit_cast(float, cs << 16); yp[(size_t)t * D + cw] = (bf16)f2bf(gelu_tanh(v)); }
        }
    }
}

constexpr int NPH = 18;
typedef const __attribute__((address_space(4))) Args* KArgs;
template <class Epi, int N_, int K_>
__device__ __forceinline__ void run_gemm(Frame& F, const bf16* A, const bf16* Bt, const Epi& E) {
    pg8::Gemm g{A, Bt, M, N_, K_}; pg8::StaticOrder S; S.init(M, N_, F.G, (int)blockIdx.x);
    pg8::gemm_phase<Epi, pg8::StaticOrder, PG8_ALIGN, PG8_SP2>(F.lds + RING_OFF, g, S, E);
}
__global__ void __launch_bounds__(NWAVES * 64, 2) mk_fwd(Args args_unused) {
    extern __shared__ __attribute__((aligned(16))) unsigned char lds[];
    const KArgs kp0 = (KArgs)__builtin_amdgcn_kernarg_segment_ptr();
    Frame F;
    F.lds = (LAS unsigned char*)lds;
    F.MISC = (volatile LAS unsigned*)(F.lds + MISC_OFF);
    F.tid = threadIdx.x; F.lane = F.tid & 63; F.wave = __builtin_amdgcn_readfirstlane(F.tid >> 6);
    F.G = gridDim.x; { const int bx = blockIdx.x; F.vcu = (F.G % 8 == 0) ? (bx % 8) * (F.G / 8) + bx / 8 : bx; }
    F.ws = kp0->ws; F.out = kp0->out;
    F.ctl = (gu32*)(F.ws + WS_CTL);
    for (int u = F.tid; u < (LDS_BYTES - LDSCTL_OFF) / 4; u += NWAVES * 64) ((LAS unsigned*)(F.lds + LDSCTL_OFF))[u] = 0u;
    __syncthreads();
    const int lo = kp0->ph_lo, hi = kp0->ph_hi;
    XcdBarrier bar; bar.bar = (unsigned*)(F.ctl + CW_BAR); bar.x = 0; bar.st = nullptr;
    if (hi - lo > 1) bar = xcd_barrier_post((unsigned*)(F.ctl + CW_BAR), F.MISC + 8);
#define IN(k) (lo <= (k) && (k) < hi)
#define SEAM(k) do { if (IN(k) && IN((k) + 1)) xcd_barrier(bar); } while (0)
#define PHASE(k) if (IN(k)) { KArgs ap = kp0; asm volatile("" : "+s"(ap)); unsigned char* ws = ap->ws; F.ws = ws; F.out = ap->out; (void)ws;
#define ENDPHASE(k) } SEAM(k);
    PHASE(0) { Args a; for (int i = 0; i < 24; ++i) a.in[i] = ap->in[i]; a.out = ap->out; a.ws = ws; a.ph_lo = 0; a.ph_hi = 0; p0_prologue(F, a); } ENDPHASE(0)
    PHASE(1) flog_naive(F, ap->in[2]); ENDPHASE(1)
    PHASE(2) { pg8::EpiBf16<0> E{(bf16*)(ws + WS_Q), D, nullptr, D, (size_t)(WS_K - WS_Q) / 2, 1.0f};
               run_gemm<pg8::EpiBf16<0>, 4 * D, D>(F, (const bf16*)(ws + WS_XN), (const bf16*)(ws + WS_WFOX), E); } ENDPHASE(2)
    PHASE(3) headnorm_naive(F, ap->in[3], ap->in[4]); ENDPHASE(3)
    PHASE(4) { static_assert(attn_body::ATTN_LDS_BYTES <= RING_BYTES, "attention LDS");
               const attn_body::AttnTensors AT{(const attn_body::bf16*)(ws + WS_Q), (const attn_body::bf16*)(ws + WS_K), (const attn_body::bf16*)(ws + WS_V), (attn_body::bf16*)(ws + WS_Q)};
               attn_body::attn_phase_fox<8>((char*)lds + RING_OFF, AT, (const attn_body::bf16*)(ws + WS_GT), (const float*)(ws + WS_LOGF), F.vcu, F.G); } ENDPHASE(4)
    PHASE(5) { pg8::EpiF32 E{(float*)(ws + WS_SCR), D}; run_gemm<pg8::EpiF32, D, D>(F, (const bf16*)(ws + WS_Q), (const bf16*)(ws + WS_WFO), E); } ENDPHASE(5)
    PHASE(6) nr_pass(F, (const float*)(ws + WS_SCR), ap->in[0], ap->in[18], ap->out, (bf16*)(ws + WS_XN)); ENDPHASE(6)
    PHASE(7) { pg8::EpiSwiGLU E{(bf16*)(ws + WS_H), FF}; run_gemm<pg8::EpiSwiGLU, 2 * FF, D>(F, (const bf16*)(ws + WS_XN), (const bf16*)(ws + WS_WGU0), E); } ENDPHASE(7)
    PHASE(8) { pg8::EpiF32 E{(float*)(ws + WS_SCR), D}; run_gemm<pg8::EpiF32, D, FF>(F, (const bf16*)(ws + WS_H), (const bf16*)(ws + WS_WD0), E); } ENDPHASE(8)
    PHASE(9) nr_pass(F, (const float*)(ws + WS_SCR), ap->out, ap->in[20], ap->out, (bf16*)(ws + WS_XN)); ENDPHASE(9)
    PHASE(10) { pg8::EpiBf16<0> E{(bf16*)(ws + WS_U), D, nullptr, 0, 0, 1.0f}; run_gemm<pg8::EpiBf16<0>, D, D>(F, (const bf16*)(ws + WS_XN), (const bf16*)(ws + WS_WSI), E); } ENDPHASE(10)
    PHASE(11) { Args a; for (int i = 0; i < 24; ++i) a.in[i] = ap->in[i]; a.out = ap->out; a.ws = ws; a.ph_lo = 0; a.ph_hi = 0; s5_naive(F, a); } ENDPHASE(11)
    PHASE(12) { pg8::EpiGlu E{(const bf16*)(ws + WS_Y), (bf16*)(ws + WS_Z), D}; run_gemm<pg8::EpiGlu, D, D>(F, (const bf16*)(ws + WS_Y), (const bf16*)(ws + WS_WSG), E); } ENDPHASE(12)
    PHASE(13) { pg8::EpiF32 E{(float*)(ws + WS_SCR), D}; run_gemm<pg8::EpiF32, D, D>(F, (const bf16*)(ws + WS_Z), (const bf16*)(ws + WS_WSO), E); } ENDPHASE(13)
    PHASE(14) nr_pass(F, (const float*)(ws + WS_SCR), ap->out, ap->in[18] + D, ap->out, (bf16*)(ws + WS_XN)); ENDPHASE(14)
    PHASE(15) { pg8::EpiSwiGLU E{(bf16*)(ws + WS_H), FF}; run_gemm<pg8::EpiSwiGLU, 2 * FF, D>(F, (const bf16*)(ws + WS_XN), (const bf16*)(ws + WS_WGU1), E); } ENDPHASE(15)
    PHASE(16) { pg8::EpiF32 E{(float*)(ws + WS_SCR), D}; run_gemm<pg8::EpiF32, D, FF>(F, (const bf16*)(ws + WS_H), (const bf16*)(ws + WS_WD1), E); } ENDPHASE(16)
    PHASE(17) nr_pass(F, (const float*)(ws + WS_SCR), ap->out, ap->in[20] + D, ap->out, nullptr); ENDPHASE(17)
#undef IN
#undef SEAM
#undef PHASE
#undef ENDPHASE
}

extern "C" void kernel_launch(void* const* d_in, const int* in_sizes, int n_in, void* d_out, int out_size, void* d_ws, size_t ws_size, hipStream_t stream) {
    static int grid = 0;
    if (grid == 0) {
        if (n_in != 24 || in_sizes[0] != M * D || out_size != M * D || ws_size < WS_END) { fprintf(stderr, "kernel_launch: shape/workspace mismatch (n_in %d, in0 %d, out %d, ws %zu)\n", n_in, n_in > 0 ? in_sizes[0] : -1, out_size, ws_size); grid = -1; return; }
        int dev = 0, cus = 0;
        if (hipGetDevice(&dev) != hipSuccess || hipDeviceGetAttribute(&cus, hipDeviceAttributeMultiprocessorCount, dev) != hipSuccess) { grid = -1; return; }
        if (hipFuncSetAttribute((const void*)mk_fwd, hipFuncAttributeMaxDynamicSharedMemorySize, LDS_BYTES) != hipSuccess) { fprintf(stderr, "kernel_launch: hipFuncSetAttribute failed\n"); grid = -1; return; }
        (void)hipGetLastError();
        grid = cus;
    }
    if (grid < 0) return;
    if (hipMemsetAsync((char*)d_ws + WS_CTL, 0, CTL_ZERO_BYTES, stream) != hipSuccess) return;
    Args a{};
    for (int i = 0; i < 24; ++i) a.in[i] = (const float*)d_in[i];
    a.out = (float*)d_out; a.ws = (unsigned char*)d_ws;
#if MK_ONE_LAUNCH
    a.ph_lo = 0; a.ph_hi = NPH;
    hipLaunchKernelGGL(mk_fwd, dim3(grid), dim3(NWAVES * 64), LDS_BYTES, stream, a);
#else
    for (int ph = 0; ph < NPH; ++ph) { a.ph_lo = ph; a.ph_hi = ph + 1; hipLaunchKernelGGL(mk_fwd, dim3(grid), dim3(NWAVES * 64), LDS_BYTES, stream, a); }
#endif
}
```

```cpp
#include <hip/hip_runtime.h>
#include <hip/hip_bf16.h>
#include <cstdio>
#include <cstdint>
namespace pg8 {
#define PG8_LAS __attribute__((address_space(3)))
typedef unsigned short bf16_t;
typedef short bf16x8 __attribute__((ext_vector_type(8)));
typedef float f32x4 __attribute__((ext_vector_type(4)));
typedef unsigned u32x4 __attribute__((ext_vector_type(4)));
constexpr int BM = 256, BK = 64, HALF = 128, HTB = HALF * BK * 2  , STAGE_BYTES = 8 * HTB, NXCD = 8, WGM = 8;

__host__ __device__ __forceinline__ int lds_byte(int r, int c) { const int st = (r >> 4) * 2 + (c >> 5), rr = r & 15, cc = c & 31, ob = rr * 64 + cc * 2; return st * 1024 + (ob ^ (((ob >> 9) & 1) << 5)); }
__host__ __device__ __forceinline__ void stage_rc(int b, int& R, int& C) { const int st = b / 1024, sb = b % 1024, swz = sb ^ (((sb >> 9) & 1) << 5); R = (st >> 1) * 16 + swz / 64; C = (st & 1) * 32 + (swz % 64) / 2; }
__host__ __device__ __forceinline__ int perm32(int rho) { const int n = rho >> 4, i = rho & 15; return 8 * (i >> 2) + 4 * n + (i & 3); }

struct Unit { int pm, pn; };
struct Gemm { const bf16_t* A; const bf16_t* Bt; int M, N, K; };

struct StaticOrder {
    int nM, nN, nwg, G, c;
    __host__ __device__ void init(int M, int N, int G_, int c_) { nM = M / BM; nN = N / BM; nwg = nM * nN; G = G_; c = c_; }
    __host__ __device__ bool next(int i, Unit& u) const {
        const long L = (long)i * G + c; if (L >= nwg) return false;
        int wgid = (int)L; { const int q = nwg / NXCD, r = nwg % NXCD, xcd = wgid % NXCD, off = wgid / NXCD; wgid = (xcd < r ? xcd * (q + 1) : r * (q + 1) + (xcd - r) * q) + off; }
        const int nig = WGM * nN, gid = wgid / nig, fm = gid * WGM, gsz = (nM - fm) < WGM ? (nM - fm) : WGM;
        u.pm = fm + ((wgid % nig) % gsz); u.pn = (wgid % nig) / gsz; return true;
    }
    __device__ __forceinline__ void a_ready(const Unit&) const {}
    __device__ __forceinline__ void done(const Unit&) const {}
};

__device__ __forceinline__ unsigned cvt_pk_bf16(float lo, float hi) { unsigned r; asm volatile("v_cvt_pk_bf16_f32 %0, %1, %2" : "=v"(r) : "v"(lo), "v"(hi)); return r; }
typedef float f32x2 __attribute__((ext_vector_type(2)));
__device__ __forceinline__ f32x2 gelu_pk(f32x2 v) {
    const f32x2 av = __builtin_elementwise_abs(v), d = av * 0.2316418882f + 1.0f;
    f32x2 t; t.x = __builtin_amdgcn_rcpf(d.x); t.y = __builtin_amdgcn_rcpf(d.y);
    f32x2 q = t * 0.5307027145f + (-0.7265760135f); q = q * t + 0.7107068705f; q = q * t + (-0.142248368f); q = q * t + 0.127414796f; q = q * t;
    const f32x2 s = (v * v) * (-0.72134752044f);
    f32x2 e; e.x = __builtin_amdgcn_exp2f(s.x); e.y = __builtin_amdgcn_exp2f(s.y);
    const f32x2 m = v * (q * e), r = v - m;
    f32x2 o; o.x = v.x < 0.f ? m.x : r.x; o.y = v.y < 0.f ? m.y : r.y; return o;
}

template <int ACT  > struct EpiBf16 {
    static constexpr bool PERM = true, AFTER_DRAIN = false; static_assert(ACT == 0 || ACT == 1, "EpiBf16: ACT is 0 (none) or 1 (gelu_pk)");
    bf16_t* O; int ldc; const float* bias; int split_cols; size_t split_stride; float scale0;
    __device__ __forceinline__ void operator()(const f32x4 (&acc)[2][2][4][2], const Unit& u, int wr, int wc, int fr, int fq) const {
        const int row0 = u.pm * BM + wr * 64 + fr; int colt = u.pn * BM; bf16_t* base = O;
        float sc = 1.f; if (split_cols) { const int t = colt / split_cols; base += (size_t)t * split_stride; colt -= t * split_cols; if (t == 0) sc = scale0; }
        const int col0 = colt + wc * 32 + 8 * fq, bcol0 = u.pn * BM + wc * 32 + 8 * fq;
        f32x4 bv[2][2];
#pragma unroll
        for (int bj = 0; bj < 2; ++bj)
#pragma unroll
            for (int n = 0; n < 2; ++n) bv[bj][n] = bias ? *(const f32x4*)(bias + bcol0 + bj * HALF + 4 * n) : (f32x4){0.f, 0.f, 0.f, 0.f};
#pragma unroll
        for (int ai = 0; ai < 2; ++ai)
#pragma unroll
            for (int m = 0; m < 4; ++m) { bf16_t* rowp = base + (size_t)(row0 + ai * HALF + m * 16) * ldc + col0;
#pragma unroll
                for (int bj = 0; bj < 2; ++bj) { f32x4 v0 = acc[ai][bj][m][0] + bv[bj][0], v1 = acc[ai][bj][m][1] + bv[bj][1];
                    if (ACT == 1) { f32x2 a = gelu_pk((f32x2){v0[0], v0[1]}), b = gelu_pk((f32x2){v0[2], v0[3]}), c = gelu_pk((f32x2){v1[0], v1[1]}), d = gelu_pk((f32x2){v1[2], v1[3]});
                        v0 = (f32x4){a.x, a.y, b.x, b.y}; v1 = (f32x4){c.x, c.y, d.x, d.y}; }
                    v0 = v0 * sc; v1 = v1 * sc; u32x4 w; w.x = cvt_pk_bf16(v0[0], v0[1]); w.y = cvt_pk_bf16(v0[2], v0[3]); w.z = cvt_pk_bf16(v1[0], v1[1]); w.w = cvt_pk_bf16(v1[2], v1[3]);
                    *(u32x4*)(rowp + bj * HALF) = w; } }
    }
};

struct PanelStats {
    unsigned* xbuf;
    unsigned* cnt;
    unsigned* tmo;
    int ntn; float eps;
    unsigned code;
    __device__ __forceinline__ bool run(const f32x4 (&v)[2][2][4][2], const Unit& u, int wr, int wc, int fr, int fq, PG8_LAS unsigned char* lds, int wid, int lane) const {
        typedef float f32x2v __attribute__((ext_vector_type(2)));
        PG8_LAS f32x2v* P = (PG8_LAS f32x2v*)lds;
        PG8_LAS f32x2v* S = (PG8_LAS f32x2v*)(lds + 8192);
        PG8_LAS unsigned* flag = (PG8_LAS unsigned*)(lds + 8192 + 2048);
#pragma unroll
        for (int ai = 0; ai < 2; ++ai)
#pragma unroll
            for (int m = 0; m < 4; ++m) {
                float s = 0.f;
#pragma unroll
                for (int bj = 0; bj < 2; ++bj)
#pragma unroll
                    for (int n = 0; n < 2; ++n) { const f32x4 x = v[ai][bj][m][n]; s += (x[0] + x[1]) + (x[2] + x[3]); }
                s += __shfl_xor(s, 16); s += __shfl_xor(s, 32);
                const float mw = s * (1.0f / 64.0f); float q = 0.f;
#pragma unroll
                for (int bj = 0; bj < 2; ++bj)
#pragma unroll
                    for (int n = 0; n < 2; ++n) { const f32x4 d = v[ai][bj][m][n] - mw; q += (d[0] * d[0] + d[1] * d[1]) + (d[2] * d[2] + d[3] * d[3]); }
                q += __shfl_xor(q, 16); q += __shfl_xor(q, 32);
                if (fq == 0) P[(ai * HALF + wr * 64 + m * 16 + fr) * 4 + wc] = (f32x2v){mw, q};
            }
        asm volatile("s_waitcnt lgkmcnt(0)" ::: "memory"); __builtin_amdgcn_s_barrier(); asm volatile("" ::: "memory");
#if defined(BROKEN_EXCHANGE_NO_WAIT)
#warning BROKEN CONTROL BUILD: the row-statistics exchange does not wait; results are wrong by design
        if (blockIdx.x >= 64) { const long long t0_ = clock64(); while (clock64() - t0_ < 60000) __builtin_amdgcn_s_sleep(8); }
#endif
        const int row = wid * 32 + (lane & 31);
        if (lane < 32) {
            const f32x2v a = P[row * 4 + 0], b = P[row * 4 + 1], c = P[row * 4 + 2], d = P[row * 4 + 3];
            const float mt = (a.x + b.x + c.x + d.x) * 0.25f;
            const float da = a.x - mt, db = b.x - mt, dc = c.x - mt, dd = d.x - mt;
            const float m2 = (a.y + b.y) + (c.y + d.y) + 64.0f * ((da * da + db * db) + (dc * dc + dd * dd));
            unsigned long long* slot = (unsigned long long*)xbuf + ((size_t)(u.pm * BM + row) * 4 + u.pn);
            __hip_atomic_store(slot, ((unsigned long long)__float_as_uint(m2) << 32) | __float_as_uint(mt), __ATOMIC_RELAXED, __HIP_MEMORY_SCOPE_AGENT);
        }
        asm volatile("s_waitcnt vmcnt(0)" ::: "memory");
        if (lane == 0) __hip_atomic_fetch_add(cnt + 64 * u.pm, 1u, __ATOMIC_RELAXED, __HIP_MEMORY_SCOPE_AGENT);
        if (wid == 0) {
            bool dead = false; const unsigned long long t0 = __builtin_amdgcn_s_memrealtime(); const unsigned want = 8u * (unsigned)ntn;
            for (;;) {
#if defined(BROKEN_EXCHANGE_NO_WAIT)
                break;
#endif
                if ((unsigned)__builtin_amdgcn_readfirstlane(__hip_atomic_load(cnt + 64 * u.pm, __ATOMIC_RELAXED, __HIP_MEMORY_SCOPE_AGENT)) >= want) break;
                if (__builtin_amdgcn_s_memrealtime() - t0 > 2000000ull) {
                    if (lane == 0) { unsigned expect = 0u; __hip_atomic_compare_exchange_strong(tmo + 1, &expect, code | (unsigned)(u.pm & 0xff), __ATOMIC_RELAXED, __ATOMIC_RELAXED, __HIP_MEMORY_SCOPE_AGENT);
                                     __hip_atomic_store(tmo, 1u, __ATOMIC_RELAXED, __HIP_MEMORY_SCOPE_AGENT); }
                    dead = true; break; }
                __builtin_amdgcn_s_sleep(2);
            }
            __builtin_amdgcn_fence(__ATOMIC_ACQUIRE, "agent");
            if (lane == 0) flag[0] = dead ? 1u : 0u;
        }
        asm volatile("s_waitcnt vmcnt(0) lgkmcnt(0)" ::: "memory"); __builtin_amdgcn_s_barrier(); asm volatile("" ::: "memory");
        const bool bad = flag[0] != 0u;
        if (lane < 32) {
            const unsigned long long* slot = (const unsigned long long*)xbuf + (size_t)(u.pm * BM + row) * 4; float mt[4], m2[4]; float ms = 0.f;
#pragma unroll
            for (int t = 0; t < 4; ++t) { if (t < ntn) { const unsigned long long w = __hip_atomic_load(slot + t, __ATOMIC_RELAXED, __HIP_MEMORY_SCOPE_AGENT); mt[t] = __uint_as_float((unsigned)w); m2[t] = __uint_as_float((unsigned)(w >> 32)); } else { mt[t] = 0.f; m2[t] = 0.f; } ms += mt[t]; }
            const float mean = ms / (float)ntn; float q = 0.f;
#pragma unroll
            for (int t = 0; t < 4; ++t) if (t < ntn) { const float dm = mt[t] - mean; q += m2[t] + 256.0f * dm * dm; }
            S[row] = (f32x2v){mean, 1.0f / sqrtf(q / (256.0f * (float)ntn) + eps)};
        }
        asm volatile("s_waitcnt lgkmcnt(0)" ::: "memory"); __builtin_amdgcn_s_barrier(); asm volatile("" ::: "memory");
        return bad;
    }
};
struct EpiLnRes {
    static constexpr bool PERM = false, AFTER_DRAIN = true;
    const float* base; float* out; int ldc; const float* bias; PanelStats st; unsigned poison;
    __device__ __forceinline__ void fused(f32x4 (&acc)[2][2][4][2], const Unit& u, int wr, int wc, int fr, int fq, PG8_LAS unsigned char* lds, int wid, int lane) const {
        typedef float f32x2v __attribute__((ext_vector_type(2)));
        const PG8_LAS f32x2v* S = (const PG8_LAS f32x2v*)(lds + 8192);
        const int col0 = u.pn * BM + wc * 32 + 4 * fq;
#pragma unroll
        for (int bj = 0; bj < 2; ++bj)
#pragma unroll
            for (int n = 0; n < 2; ++n) { const f32x4 bv = bias ? *(const f32x4*)(bias + col0 + bj * HALF + n * 16) : (f32x4){0.f, 0.f, 0.f, 0.f};
#pragma unroll
                for (int ai = 0; ai < 2; ++ai)
#pragma unroll
                    for (int m = 0; m < 4; ++m) acc[ai][bj][m][n] += bv; }
        f32x4 pre[4][2][2];
#pragma unroll
        for (int m = 0; m < 4; ++m) { const size_t off = (size_t)(u.pm * BM + wr * 64 + m * 16 + fr) * ldc + col0;
#pragma unroll
            for (int bj = 0; bj < 2; ++bj)
#pragma unroll
                for (int n = 0; n < 2; ++n) pre[m][bj][n] = *(const f32x4*)(base + off + bj * HALF + n * 16); }
        const bool bad = st.run(acc, u, wr, wc, fr, fq, lds, wid, lane) || poison != 0u;
        const float qnan = __builtin_nanf("");
#pragma unroll
        for (int ai = 0; ai < 2; ++ai)
#pragma unroll
            for (int m = 0; m < 4; ++m) { const int r = ai * HALF + wr * 64 + m * 16 + fr; const f32x2v sr = S[r]; const size_t off = (size_t)(u.pm * BM + r) * ldc + col0;
#pragma unroll
                for (int bj = 0; bj < 2; ++bj)
#pragma unroll
                    for (int n = 0; n < 2; ++n) { const f32x4 bs = ai == 0 ? pre[m][bj][n] : *(const f32x4*)(base + off + bj * HALF + n * 16); f32x4 o = bs + (acc[ai][bj][m][n] - sr.x) * sr.y;
                        if (bad) o = (f32x4){qnan, qnan, qnan, qnan}; *(f32x4*)(out + off + bj * HALF + n * 16) = o; }
                if (m & 1) asm volatile("" ::: "memory"); }
    }
};
struct EpiLnResLn {
    static constexpr bool PERM = false, AFTER_DRAIN = true;
    const float* base; float* out; bf16_t* xn; int ldc; const float* bias; PanelStats st1, st2; unsigned poison;
    __device__ __forceinline__ void fused(f32x4 (&acc)[2][2][4][2], const Unit& u, int wr, int wc, int fr, int fq, PG8_LAS unsigned char* lds, int wid, int lane) const {
        typedef float f32x2v __attribute__((ext_vector_type(2))); typedef unsigned u32x2v __attribute__((ext_vector_type(2)));
        const PG8_LAS f32x2v* S = (const PG8_LAS f32x2v*)(lds + 8192);
        const int col0 = u.pn * BM + wc * 32 + 4 * fq;
#pragma unroll
        for (int bj = 0; bj < 2; ++bj)
#pragma unroll
            for (int n = 0; n < 2; ++n) { const f32x4 bv = bias ? *(const f32x4*)(bias + col0 + bj * HALF + n * 16) : (f32x4){0.f, 0.f, 0.f, 0.f};
#pragma unroll
                for (int ai = 0; ai < 2; ++ai)
#pragma unroll
                    for (int m = 0; m < 4; ++m) acc[ai][bj][m][n] += bv; }
        bool bad = st1.run(acc, u, wr, wc, fr, fq, lds, wid, lane) || poison != 0u;
        const float qnan = __builtin_nanf("");
#pragma unroll
        for (int ai = 0; ai < 2; ++ai)
#pragma unroll
            for (int m = 0; m < 4; ++m) { const int r = ai * HALF + wr * 64 + m * 16 + fr; const f32x2v sr = S[r]; const size_t off = (size_t)(u.pm * BM + r) * ldc + col0;
#pragma unroll
                for (int bj = 0; bj < 2; ++bj)
#pragma unroll
                    for (int n = 0; n < 2; ++n) { const f32x4 bs = *(const f32x4*)(base + off + bj * HALF + n * 16); acc[ai][bj][m][n] = bs + (acc[ai][bj][m][n] - sr.x) * sr.y; }
                asm volatile("" : "+v"(acc[ai][0][m][0]), "+v"(acc[ai][0][m][1]), "+v"(acc[ai][1][m][0]), "+v"(acc[ai][1][m][1]));
                if (m & 1) asm volatile("" ::: "memory"); }
        const bool bad1 = bad;
        bad = st2.run(acc, u, wr, wc, fr, fq, lds, wid, lane) || bad;
#pragma unroll
        for (int ai = 0; ai < 2; ++ai)
#pragma unroll
            for (int m = 0; m < 4; ++m) { const int r = ai * HALF + wr * 64 + m * 16 + fr; const f32x2v sr = S[r]; const size_t off = (size_t)(u.pm * BM + r) * ldc + col0;
#pragma unroll
                for (int bj = 0; bj < 2; ++bj)
#pragma unroll
                    for (int n = 0; n < 2; ++n) { const f32x4 x1 = acc[ai][bj][m][n]; *(f32x4*)(out + off + bj * HALF + n * 16) = bad1 ? (f32x4){qnan, qnan, qnan, qnan} : x1;
                        const f32x4 o = (x1 - sr.x) * sr.y; u32x2v w; w.x = cvt_pk_bf16(o[0], o[1]); w.y = cvt_pk_bf16(o[2], o[3]);
                        if (bad) { w.x = 0x7fc07fc0u; w.y = 0x7fc07fc0u; } *(u32x2v*)(xn + off + bj * HALF + n * 16) = w; }
                asm volatile("" ::: "memory"); }
    }
};

template <class Epi, class Sched, bool ALIGN_EPI = false, bool SP2 = false>
__device__ __forceinline__ void gemm_phase(PG8_LAS unsigned char* lds, const Gemm g, const Sched& S, const Epi& E) {
    const int tid = threadIdx.x, wid = __builtin_amdgcn_readfirstlane(tid >> 6), lane = tid & 63, wr = wid >> 2, wc = wid & 3, fr = lane & 15, fq = lane >> 4;
    const int K = g.K, nt = K / BK;
    unsigned voffA[2], voffB[2];
#pragma unroll
    for (int i = 0; i < 2; ++i) { int R, C; stage_rc(tid * 16 + i * 8192, R, C); const int Rb = Epi::PERM ? ((R & ~31) + perm32(R & 31)) : R;
        voffA[i] = (unsigned)(R * K + C) * 2u; voffB[i] = (unsigned)(Rb * K + C) * 2u; }
    const size_t kstep = (size_t)(BK * 2);
    const size_t hstep = (size_t)HALF * K * 2;
    const size_t tstep = 2 * hstep;
    const unsigned ldsw = (unsigned)wid * 1024u;
    const int aoff = lds_byte(wr * 64 + fr, fq * 8), boff = lds_byte(wc * 32 + fr, fq * 8);
#define PG8_SA(b, h) (((b) * 2 + (h)) * HTB)
#define PG8_SB(b, h) ((4 + (b) * 2 + (h)) * HTB)
#define PG8_STAGE(bufoff, gbase, voff) do { _Pragma("unroll") for (int _i = 0; _i < 2; ++_i) \
        __builtin_amdgcn_global_load_lds((const unsigned*)((const char*)(gbase) + (voff)[_i]), (PG8_LAS unsigned*)(lds + (bufoff) + ldsw + _i * 8192), 16, 0, 0); } while (0)
#define PG8_LDA(dst, b, h) do { _Pragma("unroll") for (int m = 0; m < 4; ++m) _Pragma("unroll") for (int k = 0; k < 2; ++k) dst[m][k] = *(const PG8_LAS bf16x8*)(lds + PG8_SA(b, h) + aoff + m * 2048 + k * 1024); } while (0)
#define PG8_LDB(dst, b, h) do { _Pragma("unroll") for (int n = 0; n < 2; ++n) _Pragma("unroll") for (int k = 0; k < 2; ++k) dst[n][k] = *(const PG8_LAS bf16x8*)(lds + PG8_SB(b, h) + boff + n * 2048 + k * 1024); } while (0)
#define PG8_MMA(ai, bj, At, Bt) do { __builtin_amdgcn_s_setprio(1); _Pragma("unroll") for (int m = 0; m < 4; ++m) _Pragma("unroll") for (int n = 0; n < 2; ++n) _Pragma("unroll") for (int k = 0; k < 2; ++k) \
        acc[ai][bj][m][n] = __builtin_amdgcn_mfma_f32_16x16x32_bf16(Bt[n][k], At[m][k], acc[ai][bj][m][n], 0, 0, 0); __builtin_amdgcn_s_setprio(0); } while (0)
#define PG8_WAIT_V(n) asm volatile("s_waitcnt vmcnt(" #n ")" ::: "memory")
#define PG8_WAIT_L(n) asm volatile("s_waitcnt lgkmcnt(" #n ")" ::: "memory")
#define PG8_BAR __builtin_amdgcn_s_barrier()
#define PG8_SCHED __builtin_amdgcn_sched_barrier(0)
    Unit cur, nxt; int ui = 0;
    if (!S.next(0, cur)) return;
    f32x4 acc[2][2][4][2];
#pragma unroll
    for (int a = 0; a < 2; ++a)
#pragma unroll
        for (int b = 0; b < 2; ++b)
#pragma unroll
            for (int m = 0; m < 4; ++m)
#pragma unroll
                for (int n = 0; n < 2; ++n) acc[a][b][m][n] = (f32x4){0.f, 0.f, 0.f, 0.f};
    bf16x8 At[4][2], B0[2][2], B1[2][2];
    const char* cA = (const char*)g.A + (size_t)cur.pm * tstep; const char* cB = (const char*)g.Bt + (size_t)cur.pn * tstep;
    S.a_ready(cur);
    if constexpr (SP2) {
        PG8_STAGE(PG8_SB(0, 0), cB, voffB); PG8_STAGE(PG8_SB(0, 1), cB + hstep, voffB); PG8_STAGE(PG8_SA(0, 0), cA, voffA); PG8_STAGE(PG8_SA(0, 1), cA + hstep, voffA);
        if (wr == 1) PG8_BAR;
        PG8_WAIT_V(2); PG8_BAR;
        PG8_STAGE(PG8_SB(1, 0), cB + kstep, voffB); PG8_STAGE(PG8_SA(1, 0), cA + kstep, voffA); PG8_STAGE(PG8_SB(1, 1), cB + hstep + kstep, voffB);
        PG8_WAIT_V(6); PG8_BAR;
    } else {
        PG8_STAGE(PG8_SB(0, 0), cB, voffB); PG8_STAGE(PG8_SA(0, 0), cA, voffA); PG8_STAGE(PG8_SB(0, 1), cB + hstep, voffB); PG8_STAGE(PG8_SA(0, 1), cA + hstep, voffA);
        if (wr == 1) PG8_BAR;
        PG8_WAIT_V(4); PG8_BAR;
        PG8_STAGE(PG8_SB(1, 0), cB + kstep, voffB); PG8_STAGE(PG8_SA(1, 0), cA + kstep, voffA); PG8_STAGE(PG8_SB(1, 1), cB + hstep + kstep, voffB);
        PG8_WAIT_V(6); PG8_BAR;
    }
    for (;;) {
        const bool has_next = S.next(ui + 1, nxt);
        const char* nA = has_next ? (const char*)g.A + (size_t)nxt.pm * tstep : cA; const char* nB = has_next ? (const char*)g.Bt + (size_t)nxt.pn * tstep : cB;
        for (int t = 0; t < nt; t += 2) {
            const bool last = (t == nt - 2);
            const char* a1 = cA + (size_t)(t + 1) * kstep;
            const char* a2 = last ? nA : cA + (size_t)(t + 2) * kstep; const char* b2 = last ? nB : cB + (size_t)(t + 2) * kstep;
            const char* a3 = a2 + kstep; const char* b3 = b2 + kstep;
            if (last && has_next) S.a_ready(nxt);
            if constexpr (SP2) {
            PG8_LDB(B0, 0, 0); PG8_LDB(B1, 0, 1); PG8_SCHED; PG8_LDA(At, 0, 0); PG8_STAGE(PG8_SA(1, 1), a1 + hstep, voffA);
            PG8_WAIT_V(8); PG8_WAIT_L(0); PG8_BAR; PG8_MMA(0, 0, At, B0); PG8_MMA(0, 1, At, B1); PG8_BAR; PG8_SCHED;
            PG8_LDA(At, 0, 1); PG8_STAGE(PG8_SB(0, 0), b2, voffB); PG8_STAGE(PG8_SB(0, 1), b2 + hstep, voffB); PG8_STAGE(PG8_SA(0, 0), a2, voffA);
            PG8_WAIT_V(8); PG8_WAIT_L(0); PG8_BAR; PG8_MMA(1, 0, At, B0); PG8_MMA(1, 1, At, B1); PG8_BAR; PG8_SCHED;
            PG8_LDB(B0, 1, 0); PG8_LDB(B1, 1, 1); PG8_SCHED; PG8_LDA(At, 1, 0); PG8_STAGE(PG8_SA(0, 1), a2 + hstep, voffA);
            PG8_WAIT_V(8); PG8_WAIT_L(0); PG8_BAR; PG8_MMA(0, 0, At, B0); PG8_MMA(0, 1, At, B1); PG8_BAR; PG8_SCHED;
            PG8_LDA(At, 1, 1); PG8_STAGE(PG8_SB(1, 0), b3, voffB); PG8_STAGE(PG8_SB(1, 1), b3 + hstep, voffB); PG8_STAGE(PG8_SA(1, 0), a3, voffA);
            PG8_WAIT_V(8); PG8_WAIT_L(0); PG8_BAR; PG8_MMA(1, 0, At, B0); PG8_MMA(1, 1, At, B1); PG8_BAR; PG8_SCHED;
            } else {
            PG8_LDB(B0, 0, 0); PG8_SCHED; PG8_LDA(At, 0, 0); PG8_STAGE(PG8_SA(1, 1), a1 + hstep, voffA);
            PG8_WAIT_L(8); PG8_BAR; PG8_WAIT_L(0); PG8_MMA(0, 0, At, B0); PG8_BAR; PG8_SCHED;
            PG8_LDB(B1, 0, 1); PG8_STAGE(PG8_SB(0, 0), b2, voffB);
            PG8_BAR; PG8_WAIT_L(0); PG8_MMA(0, 1, At, B1); PG8_BAR;
            PG8_LDA(At, 0, 1); PG8_STAGE(PG8_SA(0, 0), a2, voffA);
            PG8_BAR; PG8_WAIT_L(0); PG8_MMA(1, 0, At, B0); PG8_BAR; PG8_SCHED;
            PG8_STAGE(PG8_SB(0, 1), b2 + hstep, voffB);
            PG8_WAIT_V(6); PG8_BAR; PG8_MMA(1, 1, At, B1); PG8_BAR;
            PG8_LDB(B0, 1, 0); PG8_SCHED; PG8_LDA(At, 1, 0); PG8_STAGE(PG8_SA(0, 1), a2 + hstep, voffA);
            PG8_WAIT_L(8); PG8_BAR; PG8_WAIT_L(0); PG8_MMA(0, 0, At, B0); PG8_BAR; PG8_SCHED;
            PG8_LDB(B1, 1, 1); PG8_STAGE(PG8_SB(1, 0), b3, voffB);
            PG8_BAR; PG8_WAIT_L(0); PG8_MMA(0, 1, At, B1); PG8_BAR;
            PG8_LDA(At, 1, 1); PG8_STAGE(PG8_SA(1, 0), a3, voffA);
            PG8_BAR; PG8_WAIT_L(0); PG8_MMA(1, 0, At, B0); PG8_BAR; PG8_SCHED;
            PG8_STAGE(PG8_SB(1, 1), b3 + hstep, voffB);
            PG8_WAIT_V(6); PG8_BAR; PG8_MMA(1, 1, At, B1); PG8_BAR;
            }
        }
        if constexpr (ALIGN_EPI) { if (wr == 0) PG8_BAR; }
        if constexpr (!Epi::AFTER_DRAIN) { E(acc, cur, wr, wc, fr, fq); S.done(cur); }
        if (!has_next) break;
#pragma unroll
        for (int a = 0; a < 2; ++a)
#pragma unroll
            for (int b = 0; b < 2; ++b)
#pragma unroll
                for (int m = 0; m < 4; ++m)
#pragma unroll
                    for (int n = 0; n < 2; ++n) acc[a][b][m][n] = (f32x4){0.f, 0.f, 0.f, 0.f};
        cur = nxt; cA = nA; cB = nB; ++ui;
        if constexpr (ALIGN_EPI) { if (wr == 1) PG8_BAR; }
    }
    PG8_WAIT_V(0);
    if constexpr (!ALIGN_EPI) { if (wr == 0) PG8_BAR; }
    PG8_BAR;
    if constexpr (Epi::AFTER_DRAIN) { E.fused(acc, cur, wr, wc, fr, fq, lds, wid, lane); S.done(cur); }
#undef PG8_SA
#undef PG8_SB
#undef PG8_STAGE
#undef PG8_LDA
#undef PG8_LDB
#undef PG8_MMA
#undef PG8_WAIT_V
#undef PG8_WAIT_L
#undef PG8_BAR
#undef PG8_SCHED
}
}
namespace pg8 {
struct EpiF32 {
    static constexpr bool PERM = false, AFTER_DRAIN = false;
    float* C; int ldc;
    __device__ __forceinline__ void operator()(const f32x4 (&acc)[2][2][4][2], const Unit& u, int wr, int wc, int fr, int fq) const {
        const int row0 = u.pm * BM + wr * 64 + fr, col0 = u.pn * BM + wc * 32 + 4 * fq;
#pragma unroll
        for (int ai = 0; ai < 2; ++ai)
#pragma unroll
            for (int m = 0; m < 4; ++m) { float* rowp = C + (size_t)(row0 + ai * HALF + m * 16) * ldc + col0;
#pragma unroll
                for (int bj = 0; bj < 2; ++bj)
#pragma unroll
                    for (int n = 0; n < 2; ++n) *(f32x4*)(rowp + bj * HALF + n * 16) = acc[ai][bj][m][n]; }
    }
};
__device__ __forceinline__ float sigmoid_f(float v) { return __builtin_amdgcn_rcpf(1.0f + __builtin_amdgcn_exp2f(-1.4426950408889634f * v)); }
struct EpiSwiGLU {
    static constexpr bool PERM = true, AFTER_DRAIN = false;
    bf16_t* Hh; int ldh;
    __device__ __forceinline__ void operator()(const f32x4 (&acc)[2][2][4][2], const Unit& u, int wr, int wc, int fr, int fq) const {
        const int row0 = u.pm * BM + wr * 64 + fr, col0 = u.pn * HALF + wc * 32 + 8 * fq;
#pragma unroll
        for (int ai = 0; ai < 2; ++ai)
#pragma unroll
            for (int m = 0; m < 4; ++m) { bf16_t* rowp = Hh + (size_t)(row0 + ai * HALF + m * 16) * ldh + col0;
                float h[8];
#pragma unroll
                for (int n = 0; n < 2; ++n)
#pragma unroll
                    for (int e = 0; e < 4; ++e) { const float g = acc[ai][0][m][n][e], up = acc[ai][1][m][n][e]; h[4 * n + e] = g * sigmoid_f(g) * up; }
                u32x4 w; w.x = cvt_pk_bf16(h[0], h[1]); w.y = cvt_pk_bf16(h[2], h[3]); w.z = cvt_pk_bf16(h[4], h[5]); w.w = cvt_pk_bf16(h[6], h[7]);
                *(u32x4*)rowp = w; }
    }
};
__device__ __forceinline__ float bf_lo(unsigned w) { return __builtin_bit_cast(float, w << 16); }
__device__ __forceinline__ float bf_hi(unsigned w) { return __builtin_bit_cast(float, w & 0xffff0000u); }
struct EpiGlu {
    static constexpr bool PERM = true, AFTER_DRAIN = false;
    const bf16_t* Y; bf16_t* Z; int ldc;
    __device__ __forceinline__ void operator()(const f32x4 (&acc)[2][2][4][2], const Unit& u, int wr, int wc, int fr, int fq) const {
        const int row0 = u.pm * BM + wr * 64 + fr, col0 = u.pn * BM + wc * 32 + 8 * fq;
#pragma unroll
        for (int ai = 0; ai < 2; ++ai)
#pragma unroll
            for (int m = 0; m < 4; ++m) { const size_t off = (size_t)(row0 + ai * HALF + m * 16) * ldc + col0;
#pragma unroll
                for (int bj = 0; bj < 2; ++bj) { const u32x4 y = *(const u32x4*)(Y + off + bj * HALF); const f32x4 a0 = acc[ai][bj][m][0], a1 = acc[ai][bj][m][1];
                    u32x4 w;
                    w.x = cvt_pk_bf16(bf_lo(y.x) * sigmoid_f(a0[0]), bf_hi(y.x) * sigmoid_f(a0[1]));
                    w.y = cvt_pk_bf16(bf_lo(y.y) * sigmoid_f(a0[2]), bf_hi(y.y) * sigmoid_f(a0[3]));
                    w.z = cvt_pk_bf16(bf_lo(y.z) * sigmoid_f(a1[0]), bf_hi(y.z) * sigmoid_f(a1[1]));
                    w.w = cvt_pk_bf16(bf_lo(y.w) * sigmoid_f(a1[2]), bf_hi(y.w) * sigmoid_f(a1[3]));
                    *(u32x4*)(Z + off + bj * HALF) = w; } }
    }
};
}
#include <hip/hip_bf16.h>
#include <cmath>
namespace attn_body {
using bf16=__hip_bfloat16;
using bf16x8=__attribute__((ext_vector_type(8)))short;
using s16x4=__attribute__((ext_vector_type(4)))short;
using f32x16=__attribute__((ext_vector_type(16)))float;
using u32x4=__attribute__((ext_vector_type(4)))unsigned;
constexpr int BATCH=16,NHEAD=16,SEQ=2048,D=64,DM=NHEAD*D;
constexpr int NW=8,QBLK=32,QB=QBLK*NW,KVBLK=64,NQB=SEQ/QB;
constexpr int ATTN_PITCH=DM, ATTN_UNIT_ROWS=QB;
__device__ __forceinline__ int crow(int r,int hi){return (r&3)+8*(r>>2)+4*hi;}
#define SBAR() __builtin_amdgcn_sched_barrier(0)
__device__ __forceinline__ void cmask(f32x16&p0,f32x16&p1,int jb,int qrel,int hi){
  const float NEG=-INFINITY; int kb=64*jb+4*hi;
  #pragma unroll
  for(int r=0;r<16;++r){int kv=kb+(r&3)+8*(r>>2); if(kv>qrel)p0[r]=NEG; if(kv+32>qrel)p1[r]=NEG;}
}

constexpr int NSLOT=3, SLOTB=8192;
constexpr int LDS_K=0, LDS_V=NSLOT*SLOTB, LDS_WS=2*NSLOT*SLOTB, LDS_OST=LDS_WS+NW*64*4, LDS_BT=86016, LDS_BZERO=LDS_BT+SEQ*16, LDS_BYTES=LDS_BZERO+16;
constexpr float C2=0.125f*1.4426950408889634f;
__device__ __forceinline__ void glds16(const void*gsrc,unsigned lds_dst){unsigned keep;
  asm volatile("s_mov_b32 %0, m0\n\ts_mov_b32 m0, %2\n\ts_nop 0\n\tglobal_load_lds_dwordx4 %1, off\n\ts_mov_b32 m0, %0":"=&s"(keep):"v"(gsrc),"s"(lds_dst):"memory");}
__device__ __forceinline__ float max3f(float a,float b,float c){float r;asm("v_max3_f32 %0, %1, %2, %3":"=v"(r):"v"(a),"v"(b),"v"(c));return r;}
__device__ __forceinline__ float max2f(float a,float b){float r;asm("v_max_f32_e32 %0, %1, %2":"=v"(r):"v"(a),"v"(b));return r;}
__device__ __forceinline__ float fadd_s(float a,float b){float r;asm("v_add_f32_e32 %0, %1, %2":"=v"(r):"v"(a),"v"(b));return r;}
__device__ __forceinline__ float fsub_s(float a,float b){float r;asm("v_sub_f32_e32 %0, %1, %2":"=v"(r):"v"(a),"v"(b));return r;}
typedef float f32x2_t __attribute__((ext_vector_type(2))); typedef __bf16 bf16x2_t __attribute__((ext_vector_type(2)));
__device__ __forceinline__ unsigned cvtpk_s(float lo,float hi){f32x2_t v={lo,hi};bf16x2_t b=__builtin_convertvector(v,bf16x2_t);return __builtin_bit_cast(unsigned,b);}
#define WAIT_BAR(N) asm volatile("s_waitcnt vmcnt(" #N ") lgkmcnt(0)\n\ts_barrier":::"memory")

__device__ __forceinline__ void qkt(f32x16&p0,f32x16&p1,const char*Kslot,const bf16x8*qr,int r32,int hi){
  const char*kb=Kslot+hi*1024+r32*16;
  #pragma unroll
  for(int d0=0;d0<4;++d0){
    const bf16x8 b0=*reinterpret_cast<const bf16x8*>(kb+d0*2048);
    const bf16x8 b1=*reinterpret_cast<const bf16x8*>(kb+d0*2048+512);
    if(d0==0){p0=__builtin_amdgcn_mfma_f32_32x32x16_bf16(b0,qr[0],f32x16{},0,0,0);p1=__builtin_amdgcn_mfma_f32_32x32x16_bf16(b1,qr[0],f32x16{},0,0,0);}
    else{p0=__builtin_amdgcn_mfma_f32_32x32x16_bf16(b0,qr[d0],p0,0,0,0);p1=__builtin_amdgcn_mfma_f32_32x32x16_bf16(b1,qr[d0],p1,0,0,0);}}
}
typedef __attribute__((address_space(3))) const char* lds_cptr;
typedef short v4i16_t __attribute__((ext_vector_type(4)));
__device__ __forceinline__ void kload8(bf16x8*kf,lds_cptr kp){
  kf[0]=*(const __attribute__((address_space(3))) bf16x8*)(kp);      kf[1]=*(const __attribute__((address_space(3))) bf16x8*)(kp+512);
  kf[2]=*(const __attribute__((address_space(3))) bf16x8*)(kp+2048); kf[3]=*(const __attribute__((address_space(3))) bf16x8*)(kp+2560);
  kf[4]=*(const __attribute__((address_space(3))) bf16x8*)(kp+4096); kf[5]=*(const __attribute__((address_space(3))) bf16x8*)(kp+4608);
  kf[6]=*(const __attribute__((address_space(3))) bf16x8*)(kp+6144); kf[7]=*(const __attribute__((address_space(3))) bf16x8*)(kp+6656);
}
__device__ __forceinline__ void kload2(bf16x8*kf,lds_cptr kp,int j){ kf[2*j]=*(const __attribute__((address_space(3))) bf16x8*)(kp+j*2048); kf[2*j+1]=*(const __attribute__((address_space(3))) bf16x8*)(kp+j*2048+512); }
__device__ __forceinline__ s16x4 vtr(lds_cptr p){ return __builtin_bit_cast(s16x4,__builtin_amdgcn_ds_read_tr16_b64_v4i16((__attribute__((address_space(3))) v4i16_t*)p)); }
__device__ __forceinline__ float rowmax(const f32x16&p0,const f32x16&p1){
  float a=max3f(p0[0],p0[1],p1[0]),b=max3f(p0[2],p0[3],p1[1]);a=max3f(a,p1[2],p1[3]);
  #pragma unroll
  for(int r=4;r<16;r+=4){a=max3f(a,p0[r],p0[r+1]);b=max3f(b,p0[r+2],p0[r+3]);a=max3f(a,p1[r],p1[r+1]);b=max3f(b,p1[r+2],p1[r+3]);}
  const float m=max2f(a,b);
  auto rr=__builtin_amdgcn_permlane32_swap(__float_as_uint(m),__float_as_uint(m),false,false);
  return max2f(__uint_as_float(rr[0]),__uint_as_float(rr[1]));
}
__device__ __forceinline__ void pv(f32x16*o,int vb,bf16x8 pa0,bf16x8 pa1,bf16x8 pa2,bf16x8 pa3){
  #pragma unroll
  for(int d0=0;d0<2;++d0){s16x4 lo[4],hi[4];
    #pragma unroll
    for(int ks=0;ks<4;++ks){
      asm volatile("ds_read_b64_tr_b16 %0,%1 offset:%c2":"=&v"(lo[ks]):"v"(vb),"i"(d0*4096+ks*1024):"memory");
      asm volatile("ds_read_b64_tr_b16 %0,%1 offset:%c2":"=&v"(hi[ks]):"v"(vb),"i"(d0*4096+ks*1024+512):"memory");}
    asm volatile("s_waitcnt lgkmcnt(0)":::"memory");SBAR();
    #define PK(k) (bf16x8){lo[k][0],lo[k][1],lo[k][2],lo[k][3],hi[k][0],hi[k][1],hi[k][2],hi[k][3]}
    o[d0]=__builtin_amdgcn_mfma_f32_32x32x16_bf16(pa0,PK(0),o[d0],0,0,0);
    o[d0]=__builtin_amdgcn_mfma_f32_32x32x16_bf16(pa1,PK(1),o[d0],0,0,0);
    o[d0]=__builtin_amdgcn_mfma_f32_32x32x16_bf16(pa2,PK(2),o[d0],0,0,0);
    o[d0]=__builtin_amdgcn_mfma_f32_32x32x16_bf16(pa3,PK(3),o[d0],0,0,0);
    #undef PK
  }
}

__device__ __forceinline__ float sgm(float v){ return __builtin_amdgcn_rcpf(1.0f+__builtin_amdgcn_exp2f(-1.4426950408889634f*v)); }
#ifndef ATTN_STORE16
#define ATTN_STORE16(p,v) (*(u32x4*)(p)=(v))
#endif
template<int THRL> __device__ __forceinline__ void attn_unit(int b,int h,int qb,const bf16*Q,const bf16*__restrict__ K,const bf16*__restrict__ V,bf16*O,const bf16*__restrict__ Gt,char*shm){
  int tid=threadIdx.x; asm volatile("":"+v"(tid));
  const int lane=tid&63,r32=lane&31,hi=lane>>5; const int wid=__builtin_amdgcn_readfirstlane(tid>>6);
  const long rowbase=(long)b*SEQ; const int q0=qb*QB;
  const bf16*Qw=Q+(rowbase+q0+wid*QBLK)*DM+h*D;
  const bf16*Kh=K+rowbase*DM+h*D,*Vh=V+rowbase*DM+h*D;
  const unsigned lds0=(unsigned)(uintptr_t)shm;
  float*wsf=(float*)(shm+LDS_WS)+wid*64;
  const bf16*ksrc=Kh+(long)lane*DM+wid*8;
  const bf16*vsrc=Vh+(long)(16*(wid&3)+(lane>>2))*DM+(wid>>2)*32+(lane&3)*8;
  const unsigned kdst=lds0+LDS_K+wid*1024, vdst=lds0+LDS_V+wid*1024;
  #define DMA_K(t,slot) glds16(ksrc+(long)(t)*KVBLK*DM,(unsigned)__builtin_amdgcn_readfirstlane(kdst+(slot)))
  #define DMA_V(t,slot) glds16(vsrc+(long)(t)*KVBLK*DM,(unsigned)__builtin_amdgcn_readfirstlane(vdst+(slot)))
  const int vb0=(int)(lds0+LDS_V)+((lane>>4)&1)*32+(lane&3)*8+(4*hi+((lane&15)>>2))*64;
  const char*Kbase=shm+LDS_K; bf16x8 kf[8];
  const lds_cptr shm3=(lds_cptr)shm; const lds_cptr kp0=shm3+LDS_K+hi*1024+r32*16; const lds_cptr vp0=shm3+LDS_V+((lane>>4)&1)*32+(lane&3)*8+(4*hi+((lane&15)>>2))*64;
  const lds_cptr bt0=shm3+(hi?LDS_BZERO:(LDS_BT+r32*16)); const int bstr=hi?0:1024, bof2=hi?0:512;
  #define BFR(p) (*(const __attribute__((address_space(3))) bf16x8*)(p))
  const int NT=(q0+QB)/KVBLK;
  DMA_K(0,0);DMA_V(0,0);DMA_K(1,SLOTB);
  bf16x8 qr[4];
  #pragma unroll
  for(int d0=0;d0<4;++d0)qr[d0]=*reinterpret_cast<const bf16x8*>(&Qw[(long)r32*DM+d0*16+hi*8]);
  float mhat=0.f,l_reg=0.f;f32x16 o[2];o[0]=f32x16{};o[1]=f32x16{};
  u32x4 mfw=(u32x4){0x3F803F80u,0x00003F80u,0u,0u};
  #define SETM() do{ const float v_=-mhat; const unsigned h_=cvtpk_s(v_,0.f)&0xffffu; const float r1_=v_-__uint_as_float(h_<<16); const unsigned m_=cvtpk_s(r1_,0.f)&0xffffu; const float r2_=r1_-__uint_as_float(m_<<16); \
      const unsigned l_=cvtpk_s(r2_,0.f)&0xffffu; mfw.y=0x3F80u|(h_<<16); mfw.z=m_|(l_<<16); }while(0)
  #define MFR __builtin_bit_cast(bf16x8,mfw)
  const int qrel=wid*QBLK+r32;
  #define CMASK(P0,P1,t) do{int jb_=(t)-(NT-4); if(jb_>=0)cmask(P0,P1,jb_,qrel,hi);}while(0)
  bool resc=false;
  #define START(P0,P1) do{ const float rm=rowmax(P0,P1); resc=false; \
    { const float dl=rm; mhat=fadd_s(mhat,dl); \
      _Pragma("unroll") for(int r=0;r<16;++r){P0[r]=fsub_s(P0[r],dl);P1[r]=fsub_s(P1[r],dl);} \
      SETM(); } \
    _Pragma("unroll") for(int r=0;r<16;++r)P0[r]=__builtin_amdgcn_exp2f(P0[r]); }while(0)
  #define RESC() do{ if(resc){ asm volatile("s_waitcnt lgkmcnt(0)":::"memory"); \
      _Pragma("unroll") for(int d_=0;d_<2;++d_) _Pragma("unroll") for(int r=0;r<16;++r)o[d_][r]*=wsf[crow(r,hi)]; } }while(0)
  f32x16 pA0,pA1,pB0,pB1;
  int sl_prev=0,sl_cur=0,sl_next=SLOTB;
  #define ROT() do{sl_prev=sl_cur;sl_cur=sl_next;sl_next=(sl_next==(NSLOT-1)*SLOTB)?0:sl_next+SLOTB;}while(0)
  DMA_K(2,2*SLOTB);
  WAIT_BAR(3);
  qkt(pA0,pA1,Kbase,qr,r32,hi);
  { const bf16x8 ba_=BFR(bt0), bb_=BFR(bt0+bof2); pA0=__builtin_amdgcn_mfma_f32_32x32x16_bf16(ba_,MFR,pA0,0,0,0); pA1=__builtin_amdgcn_mfma_f32_32x32x16_bf16(bb_,MFR,pA1,0,0,0); }
  asm volatile("s_nop 15\n\ts_nop 7":"+v"(pA0),"+v"(pA1));CMASK(pA0,pA1,0);
  START(pA0,pA1);
  _Pragma("unroll") for(int r=0;r<16;++r)pA1[r]=__builtin_amdgcn_exp2f(pA1[r]);
  WAIT_BAR(0);
  DMA_K(3,0);DMA_V(1,SLOTB);
  ROT();
  kload8(kf,kp0+sl_cur);
  WAIT_BAR(2);
  s16x4 vlo[8],vhi[8]; u32x4 pw0,pw1,pw2,pw3;
  #define PKW(P,B) cvtpk_s(P[B],P[B+1])
  #define PAF(k) __builtin_bit_cast(bf16x8,pw##k)
  #define VFR(i) (bf16x8){vlo[i][0],vlo[i][1],vlo[i][2],vlo[i][3],vhi[i][0],vhi[i][1],vhi[i][2],vhi[i][3]}
  #define PIN(x) asm volatile("":"+v"(x))
  #define MX3(a,b,c) __builtin_fmaxf(__builtin_fmaxf((a),(b)),(c))
  #define GAPA(MF,A0,A1,A2,A3,W0,W1,PW) do{ MF; sacc+=A0; sacc+=A1; sacc+=A2; sacc+=A3; PIN(sacc); W0; W1; PIN(PW); SBAR(); }while(0)
  #define EX(v) __builtin_amdgcn_exp2f(v)
  #define GAPB(MF,X,B) do{ MF; X[B]=EX(X[B]); X[B+1]=EX(X[B+1]); X[B+2]=EX(X[B+2]); X[B+3]=EX(X[B+3]); PIN(X); SBAR(); }while(0)
  #define VRD(i) do{ vlo[i]=vtr(vp_+(((i)>>2)*4096+((i)&3)*1024)); vhi[i]=vtr(vp_+(((i)>>2)*4096+((i)&3)*1024+512)); }while(0)
  #define KRD(G,j) do{ if(G){ kload2(kf,kp0+sl_next,j); SBAR(); } }while(0)
  #define STEP(C0,C1,P0,P1,t,GK,GV,GL) do{ SBAR(); \
    const lds_cptr vp_=vp0+sl_prev; \
    VRD(0); SBAR(); float sacc=(P0[0]+P0[1]); \
    GAPA(C0=__builtin_amdgcn_mfma_f32_32x32x16_bf16(kf[0],qr[0],f32x16{},0,0,0), P0[2],P0[3],P0[4],P0[5],     pw0[0]=PKW(P0,0), pw0[1]=PKW(P0,2), pw0); \
    VRD(4); SBAR(); GAPA(C1=__builtin_amdgcn_mfma_f32_32x32x16_bf16(kf[1],qr[0],f32x16{},0,0,0), P0[6],P0[7],P0[8],P0[9],     pw0[2]=PKW(P0,4), pw0[3]=PKW(P0,6), pw0); \
    VRD(1); SBAR(); GAPA(C0=__builtin_amdgcn_mfma_f32_32x32x16_bf16(kf[2],qr[1],C0,0,0,0),   P0[10],P0[11],P0[12],P0[13], pw1[0]=PKW(P0,8), pw1[1]=PKW(P0,10), pw1); \
    VRD(5); SBAR(); GAPA(C1=__builtin_amdgcn_mfma_f32_32x32x16_bf16(kf[3],qr[1],C1,0,0,0),   P0[14],P0[15],P1[0],P1[1],   pw1[2]=PKW(P0,12),pw1[3]=PKW(P0,14), pw1); \
    const lds_cptr bp_=bt0+(t)*bstr; const bf16x8 bfa_=BFR(bp_), bfb_=BFR(bp_+bof2); SBAR(); \
    VRD(2); SBAR(); GAPA(C0=__builtin_amdgcn_mfma_f32_32x32x16_bf16(kf[4],qr[2],C0,0,0,0),   P1[2],P1[3],P1[4],P1[5],     pw2[0]=PKW(P1,0), pw2[1]=PKW(P1,2), pw2); \
    VRD(6); SBAR(); GAPA(C1=__builtin_amdgcn_mfma_f32_32x32x16_bf16(kf[5],qr[2],C1,0,0,0),   P1[6],P1[7],P1[8],P1[9],     pw2[2]=PKW(P1,4), pw2[3]=PKW(P1,6), pw2); \
    VRD(3); SBAR(); GAPA(C0=__builtin_amdgcn_mfma_f32_32x32x16_bf16(kf[6],qr[3],C0,0,0,0),   P1[10],P1[11],P1[12],P1[13], pw3[0]=PKW(P1,8), pw3[1]=PKW(P1,10), pw3); \
    VRD(7); SBAR(); GAPA(C1=__builtin_amdgcn_mfma_f32_32x32x16_bf16(kf[7],qr[3],C1,0,0,0),   P1[14],P1[15],0.f,0.f,       pw3[2]=PKW(P1,12),pw3[3]=PKW(P1,14), pw3); \
    l_reg+=sacc; \
    C0=__builtin_amdgcn_mfma_f32_32x32x16_bf16(bfa_,MFR,C0,0,0,0); SBAR(); C1=__builtin_amdgcn_mfma_f32_32x32x16_bf16(bfb_,MFR,C1,0,0,0); SBAR(); \
    if(GK){DMA_K((t)+3,sl_cur);} if(GV){DMA_V((t)+1,sl_next);} \
    CMASK(C0,C1,t); \
    { float a=MX3(C0[0],C0[1],C1[0]),b=MX3(C0[2],C0[3],C1[1]); a=MX3(a,C1[2],C1[3]); \
      _Pragma("unroll") for(int r=4;r<16;r+=4){a=MX3(a,C0[r],C0[r+1]);b=MX3(b,C0[r+2],C0[r+3]);a=MX3(a,C1[r],C1[r+1]);b=MX3(b,C1[r+2],C1[r+3]);} \
      float rm=__builtin_fmaxf(a,b); { auto rr=__builtin_amdgcn_permlane32_swap(__float_as_uint(rm),__float_as_uint(rm),false,false); rm=__builtin_fmaxf(__uint_as_float(rr[0]),__uint_as_float(rr[1])); } \
      resc=false; \
      if(__builtin_expect(__any(rm>(float)THRL),0)){ const float dl=__builtin_fmaxf(rm,0.f); mhat+=dl; \
        _Pragma("unroll") for(int r=0;r<16;++r){C0[r]-=dl;C1[r]-=dl;} \
        SETM(); \
        const float f=__builtin_amdgcn_exp2f(-dl); l_reg*=f; if(hi==0)wsf[r32]=f; resc=true; } } \
    SBAR(); \
    GAPB(o[0]=__builtin_amdgcn_mfma_f32_32x32x16_bf16(PAF(0),VFR(0),o[0],0,0,0), C0,0); \
    GAPB(o[1]=__builtin_amdgcn_mfma_f32_32x32x16_bf16(PAF(0),VFR(4),o[1],0,0,0), C0,4); \
    KRD(GL,0); GAPB(o[0]=__builtin_amdgcn_mfma_f32_32x32x16_bf16(PAF(1),VFR(1),o[0],0,0,0), C0,8); \
    KRD(GL,1); GAPB(o[1]=__builtin_amdgcn_mfma_f32_32x32x16_bf16(PAF(1),VFR(5),o[1],0,0,0), C0,12); \
    KRD(GL,2); GAPB(o[0]=__builtin_amdgcn_mfma_f32_32x32x16_bf16(PAF(2),VFR(2),o[0],0,0,0), C1,0); \
    KRD(GL,3); GAPB(o[1]=__builtin_amdgcn_mfma_f32_32x32x16_bf16(PAF(2),VFR(6),o[1],0,0,0), C1,4); \
    GAPB(o[0]=__builtin_amdgcn_mfma_f32_32x32x16_bf16(PAF(3),VFR(3),o[0],0,0,0), C1,8); \
    GAPB(o[1]=__builtin_amdgcn_mfma_f32_32x32x16_bf16(PAF(3),VFR(7),o[1],0,0,0), C1,12); \
    }while(0)
  int t=1;
  #undef CMASK
  #define CMASK(P0,P1,t) do{}while(0)
  for(;t+5<NT;t+=2){
    STEP(pB0,pB1,pA0,pA1,t,true,true,true);     WAIT_BAR(2); RESC(); ROT();
    STEP(pA0,pA1,pB0,pB1,t+1,true,true,true);   WAIT_BAR(2); RESC(); ROT();
  }
  #undef CMASK
  #define CMASK(P0,P1,t) do{int jb_=(t)-(NT-4); if(jb_>=0)cmask(P0,P1,jb_,qrel,hi);}while(0)
  #define ENDW(tt) do{ if((tt)+3<NT){WAIT_BAR(2);} else if((tt)+2<NT){WAIT_BAR(1);} else {WAIT_BAR(0);} }while(0)
  for(;t+1<NT;t+=2){
    STEP(pB0,pB1,pA0,pA1,t,(t+3<NT),(t+1<NT),(t+1<NT));       ENDW(t);   RESC(); ROT();
    STEP(pA0,pA1,pB0,pB1,t+1,(t+4<NT),(t+2<NT),(t+2<NT));     ENDW(t+1); RESC(); ROT();
  }
  STEP(pB0,pB1,pA0,pA1,NT-1,false,false,false); RESC();
  { float sacc=pB0[0]+pB0[1]; _Pragma("unroll") for(int r=2;r<16;++r)sacc+=pB0[r]; _Pragma("unroll") for(int r=0;r<16;++r)sacc+=pB1[r]; l_reg+=sacc;
    pw0=(u32x4){PKW(pB0,0),PKW(pB0,2),PKW(pB0,4),PKW(pB0,6)};pw1=(u32x4){PKW(pB0,8),PKW(pB0,10),PKW(pB0,12),PKW(pB0,14)};pw2=(u32x4){PKW(pB1,0),PKW(pB1,2),PKW(pB1,4),PKW(pB1,6)};pw3=(u32x4){PKW(pB1,8),PKW(pB1,10),PKW(pB1,12),PKW(pB1,14)};
    SBAR(); pv(o,vb0+sl_cur,PAF(0),PAF(1),PAF(2),PAF(3)); }
  #undef PKW
  #undef PAF
  #undef VFR
  #undef PIN
  #undef MX3
  #undef GAPA
  #undef GAPB
  #undef EX
  #undef VRD
  #undef KRD
  #undef STEP
  #undef ENDW
  {auto rr=__builtin_amdgcn_permlane32_swap(__float_as_uint(l_reg),__float_as_uint(l_reg),false,false);l_reg=__uint_as_float(rr[0])+__uint_as_float(rr[1]);}
  if(hi==0)wsf[32+r32]=l_reg;asm volatile("s_waitcnt lgkmcnt(0)":::"memory");
  float rli[16];
  #pragma unroll
  for(int r=0;r<16;++r)rli[r]=__builtin_amdgcn_rcpf(wsf[32+crow(r,hi)]);
  bf16*Ow=O+(rowbase+q0+wid*QBLK)*DM+h*D; const bf16*Gw=Gt+(rowbase+q0+wid*QBLK)*DM+h*D;
  u32x4 gt[4];
  #pragma unroll
  for(int i=0;i<4;++i){const int row=i*8+(lane>>3),ch=lane&7; gt[i]=*(const u32x4*)(Gw+(long)row*DM+ch*8);}
  { bf16*stg=(bf16*)(shm+LDS_OST)+wid*2048;
    #pragma unroll
    for(int r=0;r<16;++r){const int orow=crow(r,hi);
      #pragma unroll
      for(int d0=0;d0<2;++d0)stg[orow*64+d0*32+r32]=__float2bfloat16(o[d0][r]*rli[r]);}
    asm volatile("s_waitcnt lgkmcnt(0)":::"memory");
    #pragma unroll
    for(int i=0;i<4;++i){const int row=i*8+(lane>>3),ch=lane&7; const u32x4 v=*(const u32x4*)(stg+row*64+ch*8); const u32x4 g=gt[i]; u32x4 w;
      #define GM(a,b) cvtpk_s(__uint_as_float((a)<<16)*sgm(__uint_as_float((b)<<16)), __uint_as_float((a)&0xffff0000u)*sgm(__uint_as_float((b)&0xffff0000u)))
      w.x=GM(v.x,g.x); w.y=GM(v.y,g.y); w.z=GM(v.z,g.z); w.w=GM(v.w,g.w);
      #undef GM
      ATTN_STORE16(Ow+(long)row*DM+ch*8,w);} }
  asm volatile("s_waitcnt lgkmcnt(0)\n\ts_barrier":::"memory");
  #undef BFR
  #undef SETM
  #undef MFR
  #undef DMA_K
  #undef DMA_V
  #undef CMASK
  #undef START
  #undef RESC
  #undef ROT
}
__device__ __forceinline__ void fox_bias_table(int b,int h,const float*__restrict__ LOGF,char*shm){
  int tid=threadIdx.x; asm volatile("":"+v"(tid));
  const int lane=tid&63; const int wid=__builtin_amdgcn_readfirstlane(tid>>6);
  float*wtot=(float*)(shm+LDS_WS); u32x4*BT=(u32x4*)(shm+LDS_BT);
  const int t0=4*tid; const float*lp=LOGF+((long)b*SEQ+t0)*NHEAD+h;
  const float lf0=lp[0],lf1=lp[NHEAD],lf2=lp[2*NHEAD],lf3=lp[3*NHEAD];
  const float s1=lf0+lf1,s2=s1+lf2,s3=s2+lf3; float inc=s3;
  #pragma unroll
  for(int o=1;o<64;o<<=1){const float v=__shfl_up(inc,o); if(lane>=o)inc+=v;}
  __syncthreads();
  if(lane==63)wtot[wid]=inc;
  __syncthreads();
  float woff=0.f; for(int w=0;w<wid;++w)woff+=wtot[w];
  const float ex=inc-s3+woff; const float cs[4]={ex+lf0,ex+s1,ex+s2,ex+s3};
  #pragma unroll
  for(int i=0;i<4;++i){ const float v=-cs[i]*1.4426950408889634f;
    const unsigned hb=__builtin_bit_cast(unsigned,v); const unsigned h16=(hb+0x7fffu+((hb>>16)&1u))>>16; const float r1=v-__uint_as_float(h16<<16);
    const unsigned mb=__builtin_bit_cast(unsigned,r1); const unsigned m16=(mb+0x7fffu+((mb>>16)&1u))>>16; const float r2=r1-__uint_as_float(m16<<16);
    const unsigned lb=__builtin_bit_cast(unsigned,r2); const unsigned l16=(lb+0x7fffu+((lb>>16)&1u))>>16;
    BT[t0+i]=(u32x4){h16|(m16<<16),l16|0x3F800000u,0x3F803F80u,0u}; }
  { unsigned z0=0u; asm volatile("":"+v"(z0)); if(tid==0)*(u32x4*)(shm+LDS_BZERO)=(u32x4){z0,z0,z0,z0}; }
  __syncthreads();
}
constexpr int ATTN_LDS_BYTES=LDS_BYTES;
struct AttnTensors { const bf16* Q; const bf16* K; const bf16* V; bf16* O; };
template<int THRL=8> __device__ __forceinline__ void attn_phase_fox(char*lds,const AttnTensors&T,const bf16*Gt,const float*LOGF,int vcu,int G){
  for(int bh=vcu;bh<BATCH*NHEAD;bh+=G){ const int b=bh/NHEAD,h=bh%NHEAD;
    fox_bias_table(b,h,LOGF,lds);
    for(int qb=NQB-1;qb>=0;--qb) attn_unit<THRL>(b,h,qb,T.Q,T.K,T.V,T.O,Gt,lds);
  }
}
#undef SBAR
#undef WAIT_BAR
}
namespace s5 {
typedef float f32x16 __attribute__((ext_vector_type(16)));
typedef float f32x4 __attribute__((ext_vector_type(4)));
typedef short bf16x8 __attribute__((ext_vector_type(8)));
typedef short s16x4 __attribute__((ext_vector_type(4)));
typedef unsigned u32x4 __attribute__((ext_vector_type(4)));
typedef __attribute__((address_space(3))) char* lptr;
constexpr int SEQ = 2048, DM = 1024, CH = 16, NCH = SEQ / CH, NSEG = 4, SEGCH = NCH / NSEG, NUNIT = 8 * 64;
constexpr int LDS_X = 0, LDS_EXCH = 65536, LDS_BYTES = LDS_EXCH + 8192;
__device__ __forceinline__ unsigned cvtpk(float lo, float hi) { typedef float f2 __attribute__((ext_vector_type(2))); typedef __bf16 b2 __attribute__((ext_vector_type(2))); f2 v = {lo, hi}; b2 b = __builtin_convertvector(v, b2); return __builtin_bit_cast(unsigned, b); }
__device__ __forceinline__ bf16x8 pack8(const float (&v)[8]) { u32x4 w; w.x = cvtpk(v[0], v[1]); w.y = cvtpk(v[2], v[3]); w.z = cvtpk(v[4], v[5]); w.w = cvtpk(v[6], v[7]); return __builtin_bit_cast(bf16x8, w); }
__device__ __forceinline__ s16x4 trd(lptr p) { typedef short v4 __attribute__((ext_vector_type(4))); return __builtin_bit_cast(s16x4, __builtin_amdgcn_ds_read_tr16_b64_v4i16((__attribute__((address_space(3))) v4*)p)); }
struct Par { const float *log_dt, *lam_re, *lam_im, *b_re, *b_im, *c_re, *c_im, *dsk; };
struct LaneC { float are[2], aim[2]; bf16x8 Bf[2][2]; bf16x8 Cf[4]; bf16x8 Df; };
__device__ __forceinline__ void setup(LaneC& L, const Par& P, int g, int lane) {
    const int r32 = lane & 31, hi = lane >> 5, c16 = lane & 15, kq = lane >> 4;
    const float dt = __expf(P.log_dt[g]);
#pragma unroll
    for (int tile = 0; tile < 2; ++tile) {
        const int p = r32 + 32 * tile;
        const float lr = P.lam_re[g * 64 + p], li = P.lam_im[g * 64 + p];
        const float mag = __expf(lr * dt);
        float rev = li * dt * 0.15915494309189535f; rev -= floorf(rev);
        const float ar = mag * __builtin_amdgcn_cosf(rev), ai = mag * __builtin_amdgcn_sinf(rev);
        const float den = lr * lr + li * li, nre = ar - 1.f;
        const float zr = (nre * lr + ai * li) / den, zi = (ai * lr - nre * li) / den;
        L.are[tile] = ar; L.aim[tile] = ai;
        const f32x4* brp = (const f32x4*)(P.b_re + (size_t)(g * 64 + p) * 16 + 8 * hi); const f32x4* bip = (const f32x4*)(P.b_im + (size_t)(g * 64 + p) * 16 + 8 * hi);
        const f32x4 br0 = brp[0], br1 = brp[1], bi0 = bip[0], bi1 = bip[1];
        float re[8], im[8];
#pragma unroll
        for (int j = 0; j < 4; ++j) { re[j] = zr * br0[j] - zi * bi0[j]; im[j] = zr * bi0[j] + zi * br0[j]; re[4 + j] = zr * br1[j] - zi * bi1[j]; im[4 + j] = zr * bi1[j] + zi * br1[j]; }
        L.Bf[tile][0] = pack8(re); L.Bf[tile][1] = pack8(im);
#pragma unroll
        for (int ri = 0; ri < 2; ++ri) { const f32x4* cp = (const f32x4*)((ri ? P.c_im : P.c_re) + (size_t)(g * 16 + c16) * 64 + 32 * tile + 8 * kq); const f32x4 c0 = cp[0], c1 = cp[1]; const float sg = ri ? -1.f : 1.f;
            float cv[8];
#pragma unroll
            for (int j = 0; j < 4; ++j) { cv[j] = sg * c0[j]; cv[4 + j] = sg * c1[j]; }
            L.Cf[tile * 2 + ri] = pack8(cv); }
    }
    { const float dv = P.dsk[g * 16 + c16]; float d8[8];
#pragma unroll
      for (int j = 0; j < 8; ++j) d8[j] = (kq < 2 && 8 * kq + j == c16) ? dv : 0.f;
      L.Df = pack8(d8); }
}
__device__ __forceinline__ float gelu_t(float v) { return v * __builtin_amdgcn_rcpf(1.0f + __builtin_amdgcn_exp2f(-1.4426950408889634f * 1.5957691216f * (v + 0.044715f * v * v * v))); }
template <bool EMIT>
__device__ __forceinline__ void run_seg(const LaneC& L, const unsigned short* __restrict__ U, unsigned short* __restrict__ Y, int bp, int g, int c0, int c1, float (&xr)[2], float (&xi)[2], lptr xl, int lane) {
    const int r32 = lane & 31, hi = lane >> 5, c16 = lane & 15, kq = lane >> 4;
    const int bsel = (r32 >> 2) & 1, tok = (r32 & 3) + 4 * (r32 >> 3);
    const unsigned short* ua = U + ((size_t)(2 * bp + bsel) * SEQ + tok) * DM + g * 16 + 8 * hi;
    const unsigned short* us0 = U + ((size_t)(2 * bp) * SEQ + c16) * DM + g * 16 + 8 * (kq & 1);
    unsigned short* yb = Y + ((size_t)(2 * bp) * SEQ + 4 * kq) * DM + g * 16 + c16;
    const lptr wbase = xl + hi * 4096 + r32 * 32;
    const lptr rbase = xl + kq * 256 + (c16 >> 2) * 32 + (lane & 3) * 8;
    u32x4 un1 = *(const u32x4*)(ua + (size_t)c0 * CH * DM);
    u32x4 un2 = (c0 + 1 < c1) ? *(const u32x4*)(ua + (size_t)(c0 + 1) * CH * DM) : un1;
    for (int c = c0; c < c1; ++c) {
        const u32x4 ucur = un1; un1 = un2;
        if (c + 2 < c1) un2 = *(const u32x4*)(ua + (size_t)(c + 2) * CH * DM);
        const size_t toff = (size_t)c * CH * DM;
        u32x4 us[2];
        if (EMIT) {
#pragma unroll
            for (int hb = 0; hb < 2; ++hb) { us[hb] = (u32x4){0u, 0u, 0u, 0u}; if (kq < 2) us[hb] = *(const u32x4*)(us0 + (size_t)hb * SEQ * DM + toff); }
        }
        const bf16x8 ua8 = __builtin_bit_cast(bf16x8, ucur);
        f32x16 br[2], bi[2];
#pragma unroll
        for (int tile = 0; tile < 2; ++tile) { br[tile] = __builtin_amdgcn_mfma_f32_32x32x16_bf16(ua8, L.Bf[tile][0], f32x16{}, 0, 0, 0); bi[tile] = __builtin_amdgcn_mfma_f32_32x32x16_bf16(ua8, L.Bf[tile][1], f32x16{}, 0, 0, 0); }
#pragma unroll
        for (int r = 0; r < 16; ++r)
#pragma unroll
            for (int tile = 0; tile < 2; ++tile) {
                const float nr = __builtin_fmaf(L.are[tile], xr[tile], __builtin_fmaf(-L.aim[tile], xi[tile], br[tile][r]));
                const float ni = __builtin_fmaf(L.are[tile], xi[tile], __builtin_fmaf(L.aim[tile], xr[tile], bi[tile][r]));
                xr[tile] = nr; xi[tile] = ni; br[tile][r] = nr; bi[tile][r] = ni; }
        if (EMIT) {
#pragma unroll
            for (int tile = 0; tile < 2; ++tile)
#pragma unroll
                for (int ri = 0; ri < 2; ++ri) { const f32x16& s = ri ? bi[tile] : br[tile];
                    u32x4 w0, w1; w0.x = cvtpk(s[0], s[1]); w0.y = cvtpk(s[2], s[3]); w0.z = cvtpk(s[4], s[5]); w0.w = cvtpk(s[6], s[7]);
                    w1.x = cvtpk(s[8], s[9]); w1.y = cvtpk(s[10], s[11]); w1.z = cvtpk(s[12], s[13]); w1.w = cvtpk(s[14], s[15]);
                    *(__attribute__((address_space(3))) u32x4*)(wbase + (tile * 2 + ri) * 1024) = w0; *(__attribute__((address_space(3))) u32x4*)(wbase + (tile * 2 + ri) * 1024 + 16) = w1; }
            asm volatile("s_waitcnt lgkmcnt(0)" ::: "memory");
            f32x4 ya[2];
#pragma unroll
            for (int hb = 0; hb < 2; ++hb) { ya[hb] = (f32x4){0.f, 0.f, 0.f, 0.f};
#pragma unroll
                for (int ks = 0; ks < 4; ++ks) { const s16x4 lo = trd(rbase + hb * 4096 + ks * 1024), hh = trd(rbase + hb * 4096 + ks * 1024 + 128);
                    const bf16x8 xa = (bf16x8){lo[0], lo[1], lo[2], lo[3], hh[0], hh[1], hh[2], hh[3]};
                    ya[hb] = __builtin_amdgcn_mfma_f32_16x16x32_bf16(xa, L.Cf[ks], ya[hb], 0, 0, 0); }
                ya[hb] = __builtin_amdgcn_mfma_f32_16x16x32_bf16(__builtin_bit_cast(bf16x8, us[hb]), L.Df, ya[hb], 0, 0, 0); }
            asm volatile("" ::: "memory");
#pragma unroll
            for (int hb = 0; hb < 2; ++hb)
#pragma unroll
                for (int e = 0; e < 4; ++e) { const float v = gelu_t(ya[hb][e]); yb[((size_t)hb * SEQ + e) * DM + toff] = (unsigned short)(cvtpk(v, 0.f) & 0xffffu); }
        }
    }
}
__device__ __forceinline__ void s5_phase(const Par& P, const unsigned short* U, unsigned short* Y, char* lds, int vcu, int G) {
    int tid = threadIdx.x; asm volatile("" : "+v"(tid));
    const int lane = tid & 63; const int wave = __builtin_amdgcn_readfirstlane(tid >> 6);
    const lptr l3 = (lptr)lds; const lptr xl = l3 + LDS_X + wave * 8192;
    __attribute__((address_space(3))) f32x4* exch = (__attribute__((address_space(3))) f32x4*)(l3 + LDS_EXCH);
    for (int ub = vcu; ub < NUNIT / 2; ub += G) {
        const int unit = 2 * ub + (wave >> 2), seg = wave & 3, bp = unit >> 6, g = unit & 63;
        LaneC L; setup(L, P, g, lane);
        float xr[2] = {0.f, 0.f}, xi[2] = {0.f, 0.f};
        if (seg < NSEG - 1) run_seg<false>(L, U, Y, bp, g, seg * SEGCH, (seg + 1) * SEGCH, xr, xi, xl, lane);
        exch[wave * 64 + lane] = (f32x4){xr[0], xi[0], xr[1], xi[1]};
        __syncthreads();
        float pr[2] = {L.are[0], L.are[1]}, pi[2] = {L.aim[0], L.aim[1]};
#pragma unroll
        for (int s = 0; s < 9; ++s)
#pragma unroll
            for (int t = 0; t < 2; ++t) { const float nr = pr[t] * pr[t] - pi[t] * pi[t], ni = 2.f * pr[t] * pi[t]; pr[t] = nr; pi[t] = ni; }
        float sr[2] = {0.f, 0.f}, si[2] = {0.f, 0.f};
        for (int i = 0; i < seg; ++i) { const f32x4 e = exch[((wave & 4) + i) * 64 + lane];
            const float n0r = pr[0] * sr[0] - pi[0] * si[0] + e[0], n0i = pr[0] * si[0] + pi[0] * sr[0] + e[1];
            const float n1r = pr[1] * sr[1] - pi[1] * si[1] + e[2], n1i = pr[1] * si[1] + pi[1] * sr[1] + e[3];
            sr[0] = n0r; si[0] = n0i; sr[1] = n1r; si[1] = n1i; }
        __syncthreads();
        run_seg<true>(L, U, Y, bp, g, seg * SEGCH, (seg + 1) * SEGCH, sr, si, xl, lane);
    }
    __syncthreads();
}
}
#ifndef PG8_SP2
#define PG8_SP2 true
#endif
#ifndef PG8_ALIGN
#define PG8_ALIGN true
#endif
#ifndef MK_ONE_LAUNCH
#define MK_ONE_LAUNCH 1
#endif
constexpr int NWAVES = 8;
constexpr int BATCH = 16, SEQ = 2048, D = 1024, NH = 16, HD = 64, FF = 2816, M = BATCH * SEQ;
constexpr int NFOX = 4 * D + NH;
constexpr int NG = 64, NP = 64, GC = 16;
constexpr float EPS = 1e-6f;
constexpr float LOG2E = 1.4426950408889634f;
constexpr float C2 = 0.125f * LOG2E;
constexpr size_t MiB = 1u << 20;
constexpr size_t WS_CTL = 0, CTL_ZERO_BYTES = 1 * MiB;
constexpr size_t WS_WFOX = 2 * MiB;
constexpr size_t WS_WF = 10 * MiB;
constexpr size_t WS_WFO = 11 * MiB, WS_WSI = 13 * MiB, WS_WSG = 15 * MiB, WS_WSO = 17 * MiB;
constexpr size_t WS_WGU0 = 19 * MiB, WS_WD0 = 30 * MiB, WS_WGU1 = 36 * MiB, WS_WD1 = 47 * MiB;
constexpr size_t WS_LOGF = 54 * MiB;
constexpr size_t WS_XCH = 56 * MiB;
constexpr size_t WS_XN = 64 * MiB;
constexpr size_t WS_Q = 128 * MiB, WS_K = 192 * MiB, WS_V = 256 * MiB, WS_GT = 320 * MiB;
constexpr size_t WS_H = 128 * MiB;
constexpr size_t WS_U = 128 * MiB, WS_Y = 192 * MiB, WS_Z = 256 * MiB;
constexpr size_t WS_SCR = 320 * MiB;
constexpr size_t WS_END = 448 * MiB;
constexpr int CW_TMO = 0, CW_CODE = 1, CW_BAR = 4096;
constexpr int RING_OFF = 0, RING_BYTES = 131072;
constexpr int LDSCTL_OFF = RING_BYTES, MISC_OFF = LDSCTL_OFF + 320;
constexpr int LDS_BYTES = 147456;
#define GAS __attribute__((address_space(1)))
#define LAS __attribute__((address_space(3)))
typedef unsigned short bf16;
typedef unsigned v4u __attribute__((ext_vector_type(4)));
typedef float f32x4 __attribute__((ext_vector_type(4)));
typedef GAS unsigned gu32;
#define RLX_AGENT __ATOMIC_RELAXED, __HIP_MEMORY_SCOPE_AGENT
#define LDS_WAIT() asm volatile("s_waitcnt lgkmcnt(0)" ::: "memory")
#define VM_WAIT() asm volatile("s_waitcnt vmcnt(0)" ::: "memory")
__device__ __forceinline__ unsigned f2bf(float f) { unsigned u = __builtin_bit_cast(unsigned, f); return (u + 0x7fffu + ((u >> 16) & 1u)) >> 16; }
__device__ __forceinline__ unsigned pk2(float lo, float hi) { return f2bf(lo) | (f2bf(hi) << 16); }
__device__ __forceinline__ float bflo(unsigned w) { return __builtin_bit_cast(float, w << 16); }
__device__ __forceinline__ float bfhi(unsigned w) { return __builtin_bit_cast(float, w & 0xffff0000u); }
__device__ __forceinline__ float sigm(float v) { return __builtin_amdgcn_rcpf(1.0f + __builtin_amdgcn_exp2f(-LOG2E * v)); }

#define XB_TMO      128
#define XB_XCNT(j)  (256  + 64 * (j))
#define XB_XSUB(j)  (1280 + 64 * (j))
#define XB_XGEN(j)  (2304 + 64 * (j))
#define XB_TOP      3328
#define XB_TOPGEN   3392
#define XCD_BAR_WORDS 3456
#define XB_SPIN_CAP (1u << 18)
__device__ __forceinline__ unsigned xb_ld(unsigned* p)              { return __hip_atomic_load(p, __ATOMIC_RELAXED, __HIP_MEMORY_SCOPE_AGENT); }
__device__ __forceinline__ unsigned xb_add(unsigned* p, unsigned v) { return __hip_atomic_fetch_add(p, v, __ATOMIC_RELAXED, __HIP_MEMORY_SCOPE_AGENT); }
__device__ __forceinline__ unsigned xb_xcc_id() { return (unsigned)__builtin_amdgcn_s_getreg((3 << 11) | 20) & 0xFu; }
#define XB_SPIN(cond, bar) do { unsigned _sp = 0; while (cond) { __builtin_amdgcn_s_sleep(1); \
    if ((++_sp & 255u) == 0u) { if (xb_ld(&(bar)[XB_TMO])) break; if (_sp > XB_SPIN_CAP) { atomicAdd(&(bar)[XB_TMO], 1u); break; } } } } while (0)
struct XcdBarrier { unsigned* bar; unsigned x; volatile LAS unsigned* st; };
__device__ __forceinline__ XcdBarrier xcd_barrier_post(unsigned* bar, volatile LAS unsigned* st) {
    XcdBarrier b; b.bar = bar; b.x = xb_xcc_id(); b.st = st;
    if (threadIdx.x == 0) (void)xb_add(&bar[XB_XCNT(b.x)], 1u);
    return b;
}
__device__ __forceinline__ void xcd_barrier_complete(unsigned* bar, unsigned x, unsigned& nloc, unsigned& nx) {
    const unsigned G = gridDim.x * gridDim.y * gridDim.z;
    unsigned sum, cnt, mine, sp = 0u;
    for (;;) {
        sum = 0u; cnt = 0u; mine = 0u;
#pragma unroll
        for (unsigned j = 0; j < 16; ++j) { const unsigned c = xb_ld(&bar[XB_XCNT(j)]); sum += c; cnt += (c > 0u) ? 1u : 0u; mine = (j == x) ? c : mine; }
        if (sum == G) break;
        __builtin_amdgcn_s_sleep(1);
        if ((++sp & 255u) == 0u) { if (xb_ld(&bar[XB_TMO])) break; if (sp > XB_SPIN_CAP) { atomicAdd(&bar[XB_TMO], 1u); break; } }
    }
    nloc = mine > 0u ? mine : 1u; nx = cnt > 0u ? cnt : 1u;
}
__device__ __forceinline__ void xcd_barrier(const XcdBarrier& b) {
    asm volatile("s_waitcnt vmcnt(0)" ::: "memory");
    __syncthreads();
    if (threadIdx.x == 0) {
        unsigned* bar = b.bar;
        __builtin_amdgcn_s_waitcnt(0);
        unsigned nloc = b.st[0], nx = b.st[1];
        if (nloc == 0u) { xcd_barrier_complete(bar, b.x, nloc, nx); b.st[0] = nloc; b.st[1] = nx; }
        const unsigned old = xb_add(&bar[XB_XSUB(b.x)], 1u);
        const unsigned gen = old / nloc;
        if (old + 1u == (gen + 1u) * nloc) {
            __builtin_amdgcn_fence(__ATOMIC_RELEASE, "agent");
            asm volatile("s_waitcnt vmcnt(0)" ::: "memory");
            const unsigned og = xb_add(&bar[XB_TOP], 1u);
            const unsigned tg = og / nx;
            if (og + 1u == (tg + 1u) * nx) xb_add(&bar[XB_TOPGEN], 1u);
            else XB_SPIN(xb_ld(&bar[XB_TOPGEN]) == tg, bar);
            __builtin_amdgcn_fence(__ATOMIC_ACQUIRE, "agent");
            xb_add(&bar[XB_XGEN(b.x)], 1u);
            asm volatile("s_waitcnt vmcnt(0)" ::: "memory");
        } else {
            XB_SPIN(xb_ld(&bar[XB_XGEN(b.x)]) == gen, bar);
            __builtin_amdgcn_fence(__ATOMIC_ACQUIRE, "agent");
            asm volatile("s_waitcnt vmcnt(0)" ::: "memory");
        }
    }
    __syncthreads();
}

struct Args { const float* in[24]; float* out; unsigned char* ws; int ph_lo, ph_hi; };
struct Frame {
    LAS unsigned char* lds;
    volatile LAS unsigned* MISC;
    gu32* ctl;
    int tid, lane, wave, vcu, G;
    unsigned char* ws;
    float* out;
};
__device__ __forceinline__ float wave_sum(float v) {
#pragma unroll
    for (int o = 1; o < 64; o <<= 1) v += __shfl_xor(v, o);
    return v;
}
__device__ __forceinline__ void transpose_item(const float* W, int ldw, const float* gain, bf16* WT, int K, int k0, int n0, int drow0, LAS float* scr, int lane) {
#pragma unroll 8
    for (int i = 0; i < 32; ++i) { const int kk = 2 * i + (lane >> 5); const float g = gain ? gain[k0 + kk] : 1.f; scr[kk * 33 + (lane & 31)] = W[(size_t)(k0 + kk) * ldw + n0 + (lane & 31)] * g; }
    LDS_WAIT(); asm volatile("" ::: "memory");
    const int c = lane & 7;
#pragma unroll
    for (int j = 0; j < 4; ++j) { const int n = (lane >> 3) + 8 * j; const LAS float* s = scr + (8 * c) * 33 + n;
        v4u o; o.x = pk2(s[0 * 33], s[1 * 33]); o.y = pk2(s[2 * 33], s[3 * 33]); o.z = pk2(s[4 * 33], s[5 * 33]); o.w = pk2(s[6 * 33], s[7 * 33]);
        *(GAS v4u*)(WT + (size_t)(drow0 + n) * K + k0 + 8 * c) = o; }
    LDS_WAIT(); asm volatile("" ::: "memory");
}
__device__ __forceinline__ void rms_row_to_bf16(const float* xrow, bf16* orow, int lane) {
    const GAS f32x4* xr = (const GAS f32x4*)xrow + lane;
    f32x4 v[4]; float s = 0.f;
#pragma unroll
    for (int j = 0; j < 4; ++j) { v[j] = xr[64 * j]; s += (v[j].x * v[j].x + v[j].y * v[j].y) + (v[j].z * v[j].z + v[j].w * v[j].w); }
    const float r = 1.0f / sqrtf(wave_sum(s) * (1.f / D) + EPS);
    GAS unsigned long long* o8 = (GAS unsigned long long*)orow + lane;
#pragma unroll
    for (int j = 0; j < 4; ++j) o8[64 * j] = (unsigned long long)pk2(v[j].x * r, v[j].y * r) | ((unsigned long long)pk2(v[j].z * r, v[j].w * r) << 32);
}
__device__ __forceinline__ void p0_prologue(Frame& F, const Args& A) {
    LAS float* scr = (LAS float*)(F.lds + RING_OFF + F.wave * 16384);
    const int gw = F.vcu * NWAVES + F.wave, NGW = F.G * NWAVES;
    constexpr int I_FOX = 16 * 128, I_SQ = 16 * 32, I_FF = 16 * 88, I_DN = 44 * 32;
    constexpr int NITEMS = I_FOX + 4 * I_SQ + 4 * I_FF + 2 * I_DN;
    unsigned char* ws = F.ws;
    for (int it = gw; it < NITEMS; it += NGW) {
        int r = it; const float* W; int ldw; const float* gain; bf16* WT; int K, N, mode;
        if (r < I_FOX) { W = A.in[1]; ldw = NFOX; gain = A.in[17]; WT = (bf16*)(ws + WS_WFOX); K = D; N = 4 * D; mode = 0; }
        else if ((r -= I_FOX) < I_SQ) { W = A.in[5]; ldw = D; gain = nullptr; WT = (bf16*)(ws + WS_WFO); K = D; N = D; mode = 0; }
        else if ((r -= I_SQ) < I_SQ) { W = A.in[6]; ldw = D; gain = A.in[17] + D; WT = (bf16*)(ws + WS_WSI); K = D; N = D; mode = 0; }
        else if ((r -= I_SQ) < I_SQ) { W = A.in[15]; ldw = D; gain = nullptr; WT = (bf16*)(ws + WS_WSG); K = D; N = D; mode = 0; }
        else if ((r -= I_SQ) < I_SQ) { W = A.in[16]; ldw = D; gain = nullptr; WT = (bf16*)(ws + WS_WSO); K = D; N = D; mode = 0; }
        else if ((r -= I_SQ) < I_FF) { W = A.in[21]; ldw = FF; gain = A.in[19]; WT = (bf16*)(ws + WS_WGU0); K = D; N = FF; mode = 1; }
        else if ((r -= I_FF) < I_FF) { W = A.in[22]; ldw = FF; gain = A.in[19]; WT = (bf16*)(ws + WS_WGU0); K = D; N = FF; mode = 2; }
        else if ((r -= I_FF) < I_DN) { W = A.in[23]; ldw = D; gain = nullptr; WT = (bf16*)(ws + WS_WD0); K = FF; N = D; mode = 0; }
        else if ((r -= I_DN) < I_FF) { W = A.in[21] + (size_t)D * FF; ldw = FF; gain = A.in[19] + D; WT = (bf16*)(ws + WS_WGU1); K = D; N = FF; mode = 1; }
        else if ((r -= I_FF) < I_FF) { W = A.in[22] + (size_t)D * FF; ldw = FF; gain = A.in[19] + D; WT = (bf16*)(ws + WS_WGU1); K = D; N = FF; mode = 2; }
        else { r -= I_FF; W = A.in[23] + (size_t)FF * D; ldw = D; gain = nullptr; WT = (bf16*)(ws + WS_WD1); K = FF; N = D; mode = 0; }
        const int nnb = N / 32, kb = r / nnb, nb = r % nnb, k0 = 64 * kb, n0 = 32 * nb;
        const int drow0 = (mode == 0) ? n0 : (256 * (n0 / 128) + (n0 % 128) + (mode == 2 ? 128 : 0));
        transpose_item(W, ldw, gain, WT, K, k0, n0, drow0, scr, F.lane);
    }
    {
        const int gt = gw * 64 + F.lane, NT = NGW * 64; bf16* WF = (bf16*)(ws + WS_WF);
        for (int e = gt; e < NH * D; e += NT) { const int h = e & 15, k = e >> 4; WF[h * D + k] = (bf16)f2bf(A.in[1][(size_t)k * NFOX + 4 * D + h] * A.in[17][k]); }
    }
    bf16* XN = (bf16*)(ws + WS_XN);
    for (int m = gw; m < M; m += NGW) rms_row_to_bf16(A.in[0] + (size_t)m * D, XN + (size_t)m * D, F.lane);
}
__device__ __forceinline__ void nr_pass(Frame& F, const float* acc, const float* xin, const float* gain, float* xout, bf16* xn) {
    const int gw = F.vcu * NWAVES + F.wave, NGW = F.G * NWAVES;
    for (int m = gw; m < M; m += NGW) {
        const GAS f32x4* ar = (const GAS f32x4*)(acc + (size_t)m * D) + F.lane; const GAS f32x4* xr = (const GAS f32x4*)(xin + (size_t)m * D) + F.lane;
        const GAS f32x4* gr = (const GAS f32x4*)gain + F.lane; GAS f32x4* orow = (GAS f32x4*)(xout + (size_t)m * D) + F.lane;
        f32x4 a[4], x[4]; float s = 0.f;
#pragma unroll
        for (int j = 0; j < 4; ++j) { a[j] = ar[64 * j]; x[j] = xr[64 * j]; s += (a[j].x * a[j].x + a[j].y * a[j].y) + (a[j].z * a[j].z + a[j].w * a[j].w); }
        const float r = 1.0f / sqrtf(wave_sum(s) * (1.f / D) + EPS); float s2 = 0.f;
#pragma unroll
        for (int j = 0; j < 4; ++j) { x[j] = x[j] + a[j] * r * gr[64 * j]; orow[64 * j] = x[j]; s2 += (x[j].x * x[j].x + x[j].y * x[j].y) + (x[j].z * x[j].z + x[j].w * x[j].w); }
        if (xn) { const float r2 = 1.0f / sqrtf(wave_sum(s2) * (1.f / D) + EPS);
            GAS unsigned long long* o8 = (GAS unsigned long long*)(xn + (size_t)m * D) + F.lane;
#pragma unroll
            for (int j = 0; j < 4; ++j) o8[64 * j] = (unsigned long long)pk2(x[j].x * r2, x[j].y * r2) | ((unsigned long long)pk2(x[j].z * r2, x[j].w * r2) << 32); }
    }
}
__device__ __forceinline__ float log_sigmoid_f(float z) {
    const float e = __expf(-fabsf(z));
    const float l1p = (e < 0.01f) ? e * (1.f - e * (0.5f - e * 0.33333333f)) : __logf(1.f + e);
    return fminf(z, 0.f) - l1p;
}
__device__ __forceinline__ void flog_naive(Frame& F, const float* b_f) {
    const int gw = F.vcu * NWAVES + F.wave, NGW = F.G * NWAVES;
    const bf16* XN = (const bf16*)(F.ws + WS_XN); const bf16* WF = (const bf16*)(F.ws + WS_WF); float* LOGF = (float*)(F.ws + WS_LOGF);
    for (int m = gw; m < M; m += NGW) {
        const GAS v4u* xr = (const GAS v4u*)(XN + (size_t)m * D) + 2 * F.lane; const v4u x0 = xr[0], x1 = xr[1];
        float xv[16];
        xv[0] = bflo(x0.x); xv[1] = bfhi(x0.x); xv[2] = bflo(x0.y); xv[3] = bfhi(x0.y); xv[4] = bflo(x0.z); xv[5] = bfhi(x0.z); xv[6] = bflo(x0.w); xv[7] = bfhi(x0.w);
        xv[8] = bflo(x1.x); xv[9] = bfhi(x1.x); xv[10] = bflo(x1.y); xv[11] = bfhi(x1.y); xv[12] = bflo(x1.z); xv[13] = bfhi(x1.z); xv[14] = bflo(x1.w); xv[15] = bfhi(x1.w);
        float mine = 0.f;
#pragma unroll
        for (int h = 0; h < NH; ++h) { const GAS v4u* wr = (const GAS v4u*)(WF + (size_t)h * D) + 2 * F.lane; const v4u w0 = wr[0], w1 = wr[1];
            float p = xv[0] * bflo(w0.x) + xv[1] * bfhi(w0.x) + xv[2] * bflo(w0.y) + xv[3] * bfhi(w0.y) + xv[4] * bflo(w0.z) + xv[5] * bfhi(w0.z) + xv[6] * bflo(w0.w) + xv[7] * bfhi(w0.w)
                    + xv[8] * bflo(w1.x) + xv[9] * bfhi(w1.x) + xv[10] * bflo(w1.y) + xv[11] * bfhi(w1.y) + xv[12] * bflo(w1.z) + xv[13] * bfhi(w1.z) + xv[14] * bflo(w1.w) + xv[15] * bfhi(w1.w);
            p = wave_sum(p); if (F.lane == h) mine = p; }
        if (F.lane < NH) LOGF[(size_t)m * NH + F.lane] = log_sigmoid_f(mine + b_f[F.lane]);
    }
}
__device__ __forceinline__ void headnorm_naive(Frame& F, const float* qg, const float* kg) {
    const int gw = F.vcu * NWAVES + F.wave, NGW = F.G * NWAVES;
    for (int it = gw; it < 2 * M; it += NGW) {
        const int which = it >= M ? 1 : 0, row = it - which * M;
        bf16* base = (bf16*)(F.ws + (which ? WS_K : WS_Q)) + (size_t)row * D; const float* gn = which ? kg : qg;
        GAS v4u* p = (GAS v4u*)base + 2 * F.lane; const v4u x0 = p[0], x1 = p[1];
        float v[16];
        v[0] = bflo(x0.x); v[1] = bfhi(x0.x); v[2] = bflo(x0.y); v[3] = bfhi(x0.y); v[4] = bflo(x0.z); v[5] = bfhi(x0.z); v[6] = bflo(x0.w); v[7] = bfhi(x0.w);
        v[8] = bflo(x1.x); v[9] = bfhi(x1.x); v[10] = bflo(x1.y); v[11] = bfhi(x1.y); v[12] = bflo(x1.z); v[13] = bfhi(x1.z); v[14] = bflo(x1.w); v[15] = bfhi(x1.w);
        float s = 0.f;
#pragma unroll
        for (int i = 0; i < 16; ++i) s += v[i] * v[i];
        s += __shfl_xor(s, 1); s += __shfl_xor(s, 2);
        float r = 1.0f / sqrtf(s * (1.f / HD) + EPS); if (!which) r *= C2;
        const int d0 = 16 * (F.lane & 3);
#pragma unroll
        for (int i = 0; i < 16; ++i) v[i] = v[i] * r * gn[d0 + i];
        v4u o0, o1; o0.x = pk2(v[0], v[1]); o0.y = pk2(v[2], v[3]); o0.z = pk2(v[4], v[5]); o0.w = pk2(v[6], v[7]);
        o1.x = pk2(v[8], v[9]); o1.y = pk2(v[10], v[11]); o1.z = pk2(v[12], v[13]); o1.w = pk2(v[14], v[15]);
        p[0] = o0; p[1] = o1;
    }
}
__device__ __forceinline__ void attn_naive(Frame& F) {
    LAS float* bias2 = (LAS float*)(F.lds);
    LAS unsigned char* Kt = F.lds + 8192; LAS unsigned char* Vt = F.lds + 16384; LAS float* wtot = (LAS float*)(F.lds + 24576);
    const float* LOGF = (const float*)(F.ws + WS_LOGF);
    const bf16* Qb = (const bf16*)(F.ws + WS_Q); const bf16* Kb = (const bf16*)(F.ws + WS_K); const bf16* Vb = (const bf16*)(F.ws + WS_V); const bf16* Gb = (const bf16*)(F.ws + WS_GT);
    bf16* Ob = (bf16*)(F.ws + WS_Q);
    for (int bh = F.vcu; bh < BATCH * NH; bh += F.G) {
        const int b = bh / NH, h = bh % NH;
        __syncthreads();
        {   const int t0 = 4 * F.tid; float lf0, lf1, lf2, lf3;
            lf0 = LOGF[((size_t)b * SEQ + t0 + 0) * NH + h]; lf1 = LOGF[((size_t)b * SEQ + t0 + 1) * NH + h]; lf2 = LOGF[((size_t)b * SEQ + t0 + 2) * NH + h]; lf3 = LOGF[((size_t)b * SEQ + t0 + 3) * NH + h];
            const float s1 = lf0 + lf1, s2 = s1 + lf2, s3 = s2 + lf3; float inc = s3;
#pragma unroll
            for (int o = 1; o < 64; o <<= 1) { const float v = __shfl_up(inc, o); if (F.lane >= o) inc += v; }
            if (F.lane == 63) wtot[F.wave] = inc;
            __syncthreads();
            float woff = 0.f; for (int w = 0; w < F.wave; ++w) woff += wtot[w];
            const float ex = inc - s3 + woff;
            bias2[t0] = -(ex + lf0) * LOG2E; bias2[t0 + 1] = -(ex + s1) * LOG2E; bias2[t0 + 2] = -(ex + s2) * LOG2E; bias2[t0 + 3] = -(ex + s3) * LOG2E;
        }
        __syncthreads();
        for (int qblk = 0; qblk < 4; ++qblk) {
            const int q = 512 * qblk + F.tid; const size_t R = (size_t)b * SEQ + q;
            float qv[64], o[64];
#pragma unroll
            for (int ch = 0; ch < 8; ++ch) { const v4u w = *(const GAS v4u*)(Qb + R * D + h * HD + 8 * ch);
                qv[8 * ch] = bflo(w.x); qv[8 * ch + 1] = bfhi(w.x); qv[8 * ch + 2] = bflo(w.y); qv[8 * ch + 3] = bfhi(w.y); qv[8 * ch + 4] = bflo(w.z); qv[8 * ch + 5] = bfhi(w.z); qv[8 * ch + 6] = bflo(w.w); qv[8 * ch + 7] = bfhi(w.w); }
#pragma unroll
            for (int d = 0; d < 64; ++d) o[d] = 0.f;
            float mx = -INFINITY, l = 0.f;
            const int ntile = 8 * (qblk + 1);
            for (int jt = 0; jt < ntile; ++jt) {
                __syncthreads();
                {   const int j = F.tid >> 3, ch = F.tid & 7; const size_t src = ((size_t)b * SEQ + 64 * jt + j) * D + h * HD + 8 * ch;
                    *(LAS v4u*)(Kt + j * 128 + ch * 16) = *(const GAS v4u*)(Kb + src); *(LAS v4u*)(Vt + j * 128 + ch * 16) = *(const GAS v4u*)(Vb + src); }
                __syncthreads();
                for (int j = 0; j < 64; ++j) {
                    const int s = 64 * jt + j;
                    if (s <= q) {
                        float dot = 0.f;
#pragma unroll
                        for (int ch = 0; ch < 8; ++ch) { const v4u w = *(const LAS v4u*)(Kt + j * 128 + ch * 16);
                            dot += qv[8 * ch] * bflo(w.x) + qv[8 * ch + 1] * bfhi(w.x) + qv[8 * ch + 2] * bflo(w.y) + qv[8 * ch + 3] * bfhi(w.y) + qv[8 * ch + 4] * bflo(w.z) + qv[8 * ch + 5] * bfhi(w.z) + qv[8 * ch + 6] * bflo(w.w) + qv[8 * ch + 7] * bfhi(w.w); }
                        const float sv = dot + bias2[s];
                        if (sv > mx) { const float al = __builtin_amdgcn_exp2f(mx - sv); l *= al;
#pragma unroll
                            for (int d = 0; d < 64; ++d) o[d] *= al;
                            mx = sv; }
                        const float p = __builtin_amdgcn_exp2f(sv - mx); l += p;
#pragma unroll
                        for (int ch = 0; ch < 8; ++ch) { const v4u w = *(const LAS v4u*)(Vt + j * 128 + ch * 16);
                            o[8 * ch] += p * bflo(w.x); o[8 * ch + 1] += p * bfhi(w.x); o[8 * ch + 2] += p * bflo(w.y); o[8 * ch + 3] += p * bfhi(w.y); o[8 * ch + 4] += p * bflo(w.z); o[8 * ch + 5] += p * bfhi(w.z); o[8 * ch + 6] += p * bflo(w.w); o[8 * ch + 7] += p * bfhi(w.w); }
                    }
                }
            }
            const float il = 1.0f / l;
#pragma unroll
            for (int ch = 0; ch < 8; ++ch) { const v4u g = *(const GAS v4u*)(Gb + R * D + h * HD + 8 * ch); v4u w;
                w.x = pk2(o[8 * ch] * il * sigm(bflo(g.x)), o[8 * ch + 1] * il * sigm(bfhi(g.x))); w.y = pk2(o[8 * ch + 2] * il * sigm(bflo(g.y)), o[8 * ch + 3] * il * sigm(bfhi(g.y)));
                w.z = pk2(o[8 * ch + 4] * il * sigm(bflo(g.z)), o[8 * ch + 5] * il * sigm(bfhi(g.z))); w.w = pk2(o[8 * ch + 6] * il * sigm(bflo(g.w)), o[8 * ch + 7] * il * sigm(bfhi(g.w)));
                *(GAS v4u*)(Ob + R * D + h * HD + 8 * ch) = w; }
        }
    }
}
__device__ __forceinline__ float gelu_tanh(float v) { return v * sigm(1.5957691216f * (v + 0.044715f * v * v * v)); }
__device__ __forceinline__ void s5_naive(Frame& F, const Args& A) {
    const int gw = F.vcu * NWAVES + F.wave, NGW = F.G * NWAVES;
    const bf16* U = (const bf16*)(F.ws + WS_U); bf16* Y = (bf16*)(F.ws + WS_Y);
    for (int item = gw; item < BATCH * NG; item += NGW) {
        const int b = item / NG, g = item % NG, p = F.lane;
        const float dt = __expf(A.in[7][g]);
        const float lr = A.in[8][g * NP + p], li = A.in[9][g * NP + p];
        const float mag = __expf(lr * dt);
        float rev = li * dt * 0.15915494309189535f; rev -= floorf(rev);
        const float a_re = mag * __builtin_amdgcn_cosf(rev), a_im = mag * __builtin_amdgcn_sinf(rev);
        const float den = lr * lr + li * li, nre = a_re - 1.f;
        const float z_re = (nre * lr + a_im * li) / den, z_im = (a_im * lr - nre * li) / den;
        float bbr[16], bbi[16], cr[16], ci[16];
#pragma unroll
        for (int c = 0; c < GC; ++c) { const float br = A.in[10][(size_t)(g * NP + p) * GC + c], bi = A.in[11][(size_t)(g * NP + p) * GC + c];
            bbr[c] = z_re * br - z_im * bi; bbi[c] = z_re * bi + z_im * br;
            cr[c] = A.in[12][(size_t)(g * GC + c) * NP + p]; ci[c] = A.in[13][(size_t)(g * GC + c) * NP + p]; }
        const int cw = (F.lane >> 2) & 15;
        const float dsk = A.in[14][g * GC + cw];
        float xr = 0.f, xi = 0.f;
        const bf16* up = U + (size_t)b * SEQ * D + g * GC; bf16* yp = Y + (size_t)b * SEQ * D + g * GC;
        v4u u0 = *(const GAS v4u*)up, u1 = *(const GAS v4u*)(up + 8); unsigned us = up[cw];
        for (int t = 0; t < SEQ; ++t) {
            const v4u c0 = u0, c1 = u1; const unsigned cs = us;
            if (t + 1 < SEQ) { u0 = *(const GAS v4u*)(up + (size_t)(t + 1) * D); u1 = *(const GAS v4u*)(up + (size_t)(t + 1) * D + 8); us = up[(size_t)(t + 1) * D + cw]; }
            float uv[16];
            uv[0] = bflo(c0.x); uv[1] = bfhi(c0.x); uv[2] = bflo(c0.y); uv[3] = bfhi(c0.y); uv[4] = bflo(c0.z); uv[5] = bfhi(c0.z); uv[6] = bflo(c0.w); uv[7] = bfhi(c0.w);
            uv[8] = bflo(c1.x); uv[9] = bfhi(c1.x); uv[10] = bflo(c1.y); uv[11] = bfhi(c1.y); uv[12] = bflo(c1.z); uv[13] = bfhi(c1.z); uv[14] = bflo(c1.w); uv[15] = bfhi(c1.w);
            float bur = 0.f, bui = 0.f;
#pragma unroll
            for (int c = 0; c < GC; ++c) { bur += bbr[c] * uv[c]; bui += bbi[c] * uv[c]; }
            const float nxr = a_re * xr - a_im * xi + bur, nxi = a_re * xi + a_im * xr + bui; xr = nxr; xi = nxi;
            float y[16];
#pragma unroll
            for (int c = 0; c < GC; ++c) y[c] = cr[c] * xr - ci[c] * xi;
            const bool b5 = (F.lane & 32) != 0, b4 = (F.lane & 16) != 0, b3 = (F.lane & 8) != 0, b2 = (F.lane & 4) != 0;
            float w8[8], w4[4], w2[2];
#pragma unroll
            for (int i = 0; i < 8; ++i) { const float send = b5 ? y[i] : y[i + 8], keep = b5 ? y[i + 8] : y[i]; w8[i] = keep + __shfl_xor(send, 32); }
#pragma unroll
            for (int i = 0; i < 4; ++i) { const float send = b4 ? w8[i] : w8[i + 4], keep = b4 ? w8[i + 4] : w8[i]; w4[i] = keep + __shfl_xor(send, 16); }
#pragma unroll
            for (int i = 0; i < 2; ++i) { const float send = b3 ? w4[i] : w4[i + 2], keep = b3 ? w4[i + 2] : w4[i]; w2[i] = keep + __shfl_xor(send, 8); }
            float w1; { const float send = b2 ? w2[0] : w2[1], keep = b2 ? w2[1] : w2[0]; w1 = keep + __shfl_xor(send, 4); }
            w1 += __shfl_xor(w1, 2); w1 += __shfl_xor(w1, 1);
            if ((F.lane & 3) == 0) { const float v = w1 + dsk * __builtin_bit_cast(float, cs << 16); yp[(size_t)t * D + cw] = (bf16)f2bf(gelu_tanh(v)); }
        }
    }
}

constexpr int NPH = 18;
typedef const __attribute__((address_space(4))) Args* KArgs;
template <class Epi, int N_, int K_>
__device__ __forceinline__ void run_gemm(Frame& F, const bf16* A, const bf16* Bt, const Epi& E) {
    pg8::Gemm g{A, Bt, M, N_, K_}; pg8::StaticOrder S; S.init(M, N_, F.G, (int)blockIdx.x);
    pg8::gemm_phase<Epi, pg8::StaticOrder, PG8_ALIGN, PG8_SP2>(F.lds + RING_OFF, g, S, E);
}
__global__ void __launch_bounds__(NWAVES * 64, 2) mk_fwd(Args args_unused) {
    extern __shared__ __attribute__((aligned(16))) unsigned char lds[];
    const KArgs kp0 = (KArgs)__builtin_amdgcn_kernarg_segment_ptr();
    Frame F;
    F.lds = (LAS unsigned char*)lds;
    F.MISC = (volatile LAS unsigned*)(F.lds + MISC_OFF);
    F.tid = threadIdx.x; F.lane = F.tid & 63; F.wave = __builtin_amdgcn_readfirstlane(F.tid >> 6);
    F.G = gridDim.x; { const int bx = blockIdx.x; F.vcu = (F.G % 8 == 0) ? (bx % 8) * (F.G / 8) + bx / 8 : bx; }
    F.ws = kp0->ws; F.out = kp0->out;
    F.ctl = (gu32*)(F.ws + WS_CTL);
    for (int u = F.tid; u < (LDS_BYTES - LDSCTL_OFF) / 4; u += NWAVES * 64) ((LAS unsigned*)(F.lds + LDSCTL_OFF))[u] = 0u;
    __syncthreads();
    const int lo = kp0->ph_lo, hi = kp0->ph_hi;
    XcdBarrier bar; bar.bar = (unsigned*)(F.ctl + CW_BAR); bar.x = 0; bar.st = nullptr;
    if (hi - lo > 1) bar = xcd_barrier_post((unsigned*)(F.ctl + CW_BAR), F.MISC + 8);
#define IN(k) (lo <= (k) && (k) < hi)
#define SEAM(k) do { if (IN(k) && IN((k) + 1)) xcd_barrier(bar); } while (0)
#define PHASE(k) if (IN(k)) { KArgs ap = kp0; asm volatile("" : "+s"(ap)); unsigned char* ws = ap->ws; F.ws = ws; F.out = ap->out; (void)ws;
#define ENDPHASE(k) } SEAM(k);
    PHASE(0) { Args a; for (int i = 0; i < 24; ++i) a.in[i] = ap->in[i]; a.out = ap->out; a.ws = ws; a.ph_lo = 0; a.ph_hi = 0; p0_prologue(F, a); } ENDPHASE(0)
    PHASE(1) flog_naive(F, ap->in[2]); ENDPHASE(1)
    PHASE(2) { pg8::EpiBf16<0> E{(bf16*)(ws + WS_Q), D, nullptr, D, (size_t)(WS_K - WS_Q) / 2, 1.0f};
               run_gemm<pg8::EpiBf16<0>, 4 * D, D>(F, (const bf16*)(ws + WS_XN), (const bf16*)(ws + WS_WFOX), E); } ENDPHASE(2)
    PHASE(3) headnorm_naive(F, ap->in[3], ap->in[4]); ENDPHASE(3)
    PHASE(4) { static_assert(attn_body::ATTN_LDS_BYTES <= RING_BYTES, "attention LDS");
               const attn_body::AttnTensors AT{(const attn_body::bf16*)(ws + WS_Q), (const attn_body::bf16*)(ws + WS_K), (const attn_body::bf16*)(ws + WS_V), (attn_body::bf16*)(ws + WS_Q)};
               attn_body::attn_phase_fox<8>((char*)lds + RING_OFF, AT, (const attn_body::bf16*)(ws + WS_GT), (const float*)(ws + WS_LOGF), F.vcu, F.G); } ENDPHASE(4)
    PHASE(5) { pg8::EpiF32 E{(float*)(ws + WS_SCR), D}; run_gemm<pg8::EpiF32, D, D>(F, (const bf16*)(ws + WS_Q), (const bf16*)(ws + WS_WFO), E); } ENDPHASE(5)
    PHASE(6) nr_pass(F, (const float*)(ws + WS_SCR), ap->in[0], ap->in[18], ap->out, (bf16*)(ws + WS_XN)); ENDPHASE(6)
    PHASE(7) { pg8::EpiSwiGLU E{(bf16*)(ws + WS_H), FF}; run_gemm<pg8::EpiSwiGLU, 2 * FF, D>(F, (const bf16*)(ws + WS_XN), (const bf16*)(ws + WS_WGU0), E); } ENDPHASE(7)
    PHASE(8) { pg8::EpiF32 E{(float*)(ws + WS_SCR), D}; run_gemm<pg8::EpiF32, D, FF>(F, (const bf16*)(ws + WS_H), (const bf16*)(ws + WS_WD0), E); } ENDPHASE(8)
    PHASE(9) nr_pass(F, (const float*)(ws + WS_SCR), ap->out, ap->in[20], ap->out, (bf16*)(ws + WS_XN)); ENDPHASE(9)
    PHASE(10) { pg8::EpiBf16<0> E{(bf16*)(ws + WS_U), D, nullptr, 0, 0, 1.0f}; run_gemm<pg8::EpiBf16<0>, D, D>(F, (const bf16*)(ws + WS_XN), (const bf16*)(ws + WS_WSI), E); } ENDPHASE(10)
    PHASE(11) { static_assert(s5::LDS_BYTES <= RING_BYTES, "S5 LDS");
                const s5::Par P{ap->in[7], ap->in[8], ap->in[9], ap->in[10], ap->in[11], ap->in[12], ap->in[13], ap->in[14]};
                s5::s5_phase(P, (const unsigned short*)(ws + WS_U), (unsigned short*)(ws + WS_Y), (char*)lds + RING_OFF, F.vcu, F.G); } ENDPHASE(11)
    PHASE(12) { pg8::EpiGlu E{(const bf16*)(ws + WS_Y), (bf16*)(ws + WS_Z), D}; run_gemm<pg8::EpiGlu, D, D>(F, (const bf16*)(ws + WS_Y), (const bf16*)(ws + WS_WSG), E); } ENDPHASE(12)
    PHASE(13) { pg8::EpiF32 E{(float*)(ws + WS_SCR), D}; run_gemm<pg8::EpiF32, D, D>(F, (const bf16*)(ws + WS_Z), (const bf16*)(ws + WS_WSO), E); } ENDPHASE(13)
    PHASE(14) nr_pass(F, (const float*)(ws + WS_SCR), ap->out, ap->in[18] + D, ap->out, (bf16*)(ws + WS_XN)); ENDPHASE(14)
    PHASE(15) { pg8::EpiSwiGLU E{(bf16*)(ws + WS_H), FF}; run_gemm<pg8::EpiSwiGLU, 2 * FF, D>(F, (const bf16*)(ws + WS_XN), (const bf16*)(ws + WS_WGU1), E); } ENDPHASE(15)
    PHASE(16) { pg8::EpiF32 E{(float*)(ws + WS_SCR), D}; run_gemm<pg8::EpiF32, D, FF>(F, (const bf16*)(ws + WS_H), (const bf16*)(ws + WS_WD1), E); } ENDPHASE(16)
    PHASE(17) nr_pass(F, (const float*)(ws + WS_SCR), ap->out, ap->in[20] + D, ap->out, nullptr); ENDPHASE(17)
#undef IN
#undef SEAM
#undef PHASE
#undef ENDPHASE
}

extern "C" void kernel_launch(void* const* d_in, const int* in_sizes, int n_in, void* d_out, int out_size, void* d_ws, size_t ws_size, hipStream_t stream) {
    static int grid = 0;
    if (grid == 0) {
        if (n_in != 24 || in_sizes[0] != M * D || out_size != M * D || ws_size < WS_END) { fprintf(stderr, "kernel_launch: shape/workspace mismatch (n_in %d, in0 %d, out %d, ws %zu)\n", n_in, n_in > 0 ? in_sizes[0] : -1, out_size, ws_size); grid = -1; return; }
        int dev = 0, cus = 0;
        if (hipGetDevice(&dev) != hipSuccess || hipDeviceGetAttribute(&cus, hipDeviceAttributeMultiprocessorCount, dev) != hipSuccess) { grid = -1; return; }
        if (hipFuncSetAttribute((const void*)mk_fwd, hipFuncAttributeMaxDynamicSharedMemorySize, LDS_BYTES) != hipSuccess) { fprintf(stderr, "kernel_launch: hipFuncSetAttribute failed\n"); grid = -1; return; }
        (void)hipGetLastError();
        grid = cus;
    }
    if (grid < 0) return;
    if (hipMemsetAsync((char*)d_ws + WS_CTL, 0, CTL_ZERO_BYTES, stream) != hipSuccess) return;
    Args a{};
    for (int i = 0; i < 24; ++i) a.in[i] = (const float*)d_in[i];
    a.out = (float*)d_out; a.ws = (unsigned char*)d_ws;
#if MK_ONE_LAUNCH
    a.ph_lo = 0; a.ph_hi = NPH;
    hipLaunchKernelGGL(mk_fwd, dim3(grid), dim3(NWAVES * 64), LDS_BYTES, stream, a);
#else
    for (int ph = 0; ph < NPH; ++ph) { a.ph_lo = ph; a.ph_hi = ph + 1; hipLaunchKernelGGL(mk_fwd, dim3(grid), dim3(NWAVES * 64), LDS_BYTES, stream, a); }
#endif
}
```
